# Optimizing an MI355X kernel written in HIP

```python
import math
import jax, jax.numpy as jnp
from jax import lax
import numpy as np

D_MODEL = 2048
BATCH = 1
SEQ = 16384
DEPTH = 2

N_META = 16
GRID_W = 64
Q_BLOCK = 128
MIX_WIDTH = D_MODEL
BRANCH_W = MIX_WIDTH // 4
EPS = 1e-6
ROPE_THETA = 500000.0
AXIAL_THETA = 10000.0

A_V_DIM = 128
A_HEADS = BRANCH_W // A_V_DIM
A_QK_DIM = A_V_DIM // 2
A_ROT = A_QK_DIM // 4

B_HEAD_DIM = 128
B_HEADS = BRANCH_W // B_HEAD_DIM
B_KV_HEADS = B_HEADS // 2

C_V_DIM = 128
C_HEADS = BRANCH_W // C_V_DIM
C_NOPE = 128
C_ROPE = 64
C_Q_LORA = 3 * D_MODEL // 16
C_KV_LORA = D_MODEL // 8

POOL_WINDOWS = (2, 4, 8, 16)
D_GROUPS = len(POOL_WINDOWS)
D_GROUP_DIM = BRANCH_W // D_GROUPS

IN_SIZES = (
    A_HEADS * 2 * A_QK_DIM,
    A_HEADS * 2 * A_QK_DIM,
    A_HEADS * A_V_DIM,
    BRANCH_W,
    B_HEADS * B_HEAD_DIM,
    B_KV_HEADS * B_HEAD_DIM,
    B_KV_HEADS * B_HEAD_DIM,
    BRANCH_W,
    C_Q_LORA,
    C_KV_LORA,
    C_ROPE,
    BRANCH_W,
    BRANCH_W,
    BRANCH_W,
)
IN_COLS = sum(IN_SIZES)

kernel_name = 'hybrid_parallel_heads_encoder'


def rms_norm(x, w):
    x32 = x.astype(jnp.float32)
    y = x32 * lax.rsqrt(jnp.mean(x32 * x32, axis=-1, keepdims=True) + EPS)
    return (y * w.astype(jnp.float32)).astype(x.dtype)


def rope_table(pos, dim, theta):
    inv = theta ** (-jnp.arange(0, dim, 2, dtype=jnp.float32) / dim)
    ang = pos.astype(jnp.float32)[:, None] * inv[None, :]
    return jnp.cos(ang), jnp.sin(ang)


def apply_rope(x, cos, sin):
    half = x.shape[-1] // 2
    x1, x2 = x[..., :half], x[..., half:]
    c = cos.astype(x.dtype)
    s = sin.astype(x.dtype)
    return jnp.concatenate([x1 * c - x2 * s, x1 * s + x2 * c], axis=-1)


def softmax32(s, scale):
    return jax.nn.softmax(s.astype(jnp.float32) * scale, axis=-1)


def over_query_blocks(attend, qs):
    meta = tuple(q[:, :N_META] for q in qs)

    def to_blocks(q):
        b, l = q.shape[:2]
        n = (l - N_META) // Q_BLOCK
        return jnp.moveaxis(q[:, N_META:].reshape(b, n, Q_BLOCK, *q.shape[2:]), 1, 0)

    blocks = tuple(to_blocks(q) for q in qs)
    out = lax.map(lambda qb: attend(*qb), blocks)
    out = jnp.moveaxis(out, 0, 1)
    out = out.reshape(out.shape[0], -1, *out.shape[3:])
    return jnp.concatenate([attend(*meta), out], axis=1)


def diff_attention(q_raw, k_raw, v_raw, q_norm_w, k_norm_w, lam_params, subln_w, lambda_init, cos, sin):
    b, l = q_raw.shape[:2]
    q = rms_norm(q_raw.reshape(b, l, A_HEADS, 2, A_QK_DIM), q_norm_w)
    k = rms_norm(k_raw.reshape(b, l, A_HEADS, 2, A_QK_DIM), k_norm_w)
    c, s = cos[:, None, None, :], sin[:, None, None, :]
    q = jnp.concatenate([apply_rope(q[..., :A_ROT], c, s), q[..., A_ROT:]], axis=-1)
    k = jnp.concatenate([apply_rope(k[..., :A_ROT], c, s), k[..., A_ROT:]], axis=-1)
    v = v_raw.reshape(b, l, A_HEADS, A_V_DIM)
    lp = lam_params.astype(jnp.float32)
    lam = jnp.exp(jnp.sum(lp[0] * lp[1])) - jnp.exp(jnp.sum(lp[2] * lp[3])) + lambda_init
    scale = A_QK_DIM ** -0.5

    def attend(qb):
        p = softmax32(jnp.einsum('bqhmd,bkhmd->bhmqk', qb, k), scale)
        w = (p[:, :, 0] - lam * p[:, :, 1]).astype(v.dtype)
        return jnp.einsum('bhqk,bkhd->bqhd', w, v)

    o = over_query_blocks(attend, (q,))
    o = rms_norm(o, subln_w) * (1.0 - lambda_init)
    return o.reshape(b, l, BRANCH_W)


def axial_gqa(q_raw, k_raw, v_raw, q_norm_w, k_norm_w, cos_r, sin_r, cos_c, sin_c):
    b, l = q_raw.shape[:2]
    q = rms_norm(q_raw.reshape(b, l, B_HEADS, B_HEAD_DIM), q_norm_w)
    k = rms_norm(k_raw.reshape(b, l, B_KV_HEADS, B_HEAD_DIM), k_norm_w)
    v = v_raw.reshape(b, l, B_KV_HEADS, B_HEAD_DIM)
    half = B_HEAD_DIM // 2

    def axial(t):
        return jnp.concatenate([
            apply_rope(t[..., :half], cos_r[:, None, :], sin_r[:, None, :]),
            apply_rope(t[..., half:], cos_c[:, None, :], sin_c[:, None, :])], axis=-1)

    q, k = axial(q), axial(k)
    rep = B_HEADS // B_KV_HEADS
    scale = B_HEAD_DIM ** -0.5

    def attend(qb):
        bq, nq = qb.shape[:2]
        qg = qb.reshape(bq, nq, B_KV_HEADS, rep, B_HEAD_DIM)
        p = softmax32(jnp.einsum('bqgrd,bkgd->bgrqk', qg, k), scale).astype(v.dtype)
        return jnp.einsum('bgrqk,bkgd->bqgrd', p, v).reshape(bq, nq, BRANCH_W)

    return over_query_blocks(attend, (q,))


def latent_attention(cq_raw, ckv_raw, kr_raw, q_lat_w, kv_lat_w, w_uq, w_ukv, q_norm_w, k_norm_w, cos, sin):
    b, l = cq_raw.shape[:2]
    c_q = rms_norm(cq_raw, q_lat_w)
    c_kv = rms_norm(ckv_raw, kv_lat_w)
    q = jnp.einsum('blr,rn->bln', c_q, w_uq).reshape(b, l, C_HEADS, C_NOPE + C_ROPE)
    kv = jnp.einsum('blr,rn->bln', c_kv, w_ukv).reshape(b, l, C_HEADS, C_NOPE + C_V_DIM)
    q_nope = rms_norm(q[..., :C_NOPE], q_norm_w[:C_NOPE])
    q_rope = apply_rope(rms_norm(q[..., C_NOPE:], q_norm_w[C_NOPE:]), cos[:, None, :], sin[:, None, :])
    k_nope = rms_norm(kv[..., :C_NOPE], k_norm_w[:C_NOPE])
    v = kv[..., C_NOPE:]
    k_rope = apply_rope(rms_norm(kr_raw, k_norm_w[C_NOPE:]), cos, sin)
    scale = (C_NOPE + C_ROPE) ** -0.5

    def attend(qn, qr):
        s = (jnp.einsum('bqhd,bkhd->bhqk', qn, k_nope).astype(jnp.float32)
             + jnp.einsum('bqhd,bkd->bhqk', qr, k_rope).astype(jnp.float32))
        p = softmax32(s, scale).astype(v.dtype)
        return jnp.einsum('bhqk,bkhd->bqhd', p, v).reshape(qn.shape[0], qn.shape[1], BRANCH_W)

    return over_query_blocks(attend, (q_nope, q_rope))


def multiscale_pool(u, w_group, scale):
    b, l, _ = u.shape
    u32 = u.astype(jnp.float32)
    cs = jnp.concatenate([jnp.zeros((b, 1, BRANCH_W), jnp.float32), lax.cumsum(u32, axis=1)], axis=1)
    t = jnp.arange(l)
    outs = []
    for g, w in enumerate(POOL_WINDOWS):
        lo = jnp.clip(t - w // 2, 0, l)
        hi = jnp.clip(t + w - w // 2, 0, l)
        sl = slice(g * D_GROUP_DIM, (g + 1) * D_GROUP_DIM)
        csg = cs[..., sl]
        cnt = (hi - lo).astype(jnp.float32)[None, :, None]
        mean = (jnp.take(csg, hi, axis=1) - jnp.take(csg, lo, axis=1)) / cnt
        outs.append(mean - u32[..., sl])
    pooled = jnp.stack(outs, axis=2).astype(u.dtype)
    mixed = jnp.einsum('blgc,gcd->blgd', pooled, w_group).reshape(b, l, BRANCH_W)
    return mixed * scale


def hybrid_layer(x, norm_w, w_in, w_out, a_q_norm, a_k_norm, a_lambda, a_subln, b_q_norm, b_k_norm,
                 c_q_lat_norm, c_kv_lat_norm, c_w_uq, c_w_ukv, c_q_norm, c_k_norm, d_w_group, d_scale,
                 lambda_init, tabs):
    cos_a, sin_a, cos_r, sin_r, cos_c, sin_c, cos_m, sin_m = tabs
    h = rms_norm(x, norm_w)
    proj = jnp.einsum('bld,dn->bln', h, w_in)
    split_points = [int(v) for v in np.cumsum(IN_SIZES)[:-1]]
    (aq, ak, av, ag, bq, bk, bv, bg, cq, ckv, ckr, cg, du, dg) = jnp.split(proj, split_points, axis=-1)
    ya = diff_attention(aq, ak, av, a_q_norm, a_k_norm, a_lambda, a_subln, lambda_init, cos_a, sin_a)
    yb = axial_gqa(bq, bk, bv, b_q_norm, b_k_norm, cos_r, sin_r, cos_c, sin_c)
    yc = latent_attention(cq, ckv, ckr, c_q_lat_norm, c_kv_lat_norm, c_w_uq, c_w_ukv, c_q_norm, c_k_norm, cos_m, sin_m)
    yd = multiscale_pool(du, d_w_group, d_scale)
    y = jnp.concatenate([ya * jax.nn.silu(ag), yb * jax.nn.silu(bg),
                         yc * jax.nn.silu(cg), yd * jax.nn.silu(dg)], axis=-1)
    return x + jnp.einsum('bln,nd->bld', y, w_out)


def setup_inputs(seed: int = 0) -> dict:
    key = jax.random.key(seed)
    ks = jax.random.split(key, 24)
    f32 = jnp.float32

    def nrm(k, shape, scale):
        return jax.random.normal(k, shape, f32) * scale

    def gain(k, shape):
        return 1.0 + 0.02 * jax.random.normal(k, shape, f32)

    return {
        'x': nrm(ks[0], (BATCH, SEQ, D_MODEL), 1.0),
        'meta_tokens': nrm(ks[1], (N_META, D_MODEL), 1.0),
        'norm_w': gain(ks[2], (DEPTH, D_MODEL)),
        'w_in': nrm(ks[3], (DEPTH, D_MODEL, IN_COLS), D_MODEL ** -0.5),
        'w_out': nrm(ks[4], (DEPTH, MIX_WIDTH, D_MODEL), MIX_WIDTH ** -0.5),
        'a_q_norm': gain(ks[5], (DEPTH, A_QK_DIM)),
        'a_k_norm': gain(ks[6], (DEPTH, A_QK_DIM)),
        'a_lambda': nrm(ks[7], (DEPTH, 4, A_QK_DIM), 0.1),
        'a_subln': gain(ks[8], (DEPTH, A_V_DIM)),
        'b_q_norm': gain(ks[9], (DEPTH, B_HEAD_DIM)),
        'b_k_norm': gain(ks[10], (DEPTH, B_HEAD_DIM)),
        'c_q_lat_norm': gain(ks[11], (DEPTH, C_Q_LORA)),
        'c_kv_lat_norm': gain(ks[12], (DEPTH, C_KV_LORA)),
        'c_w_uq': nrm(ks[13], (DEPTH, C_Q_LORA, C_HEADS * (C_NOPE + C_ROPE)), C_Q_LORA ** -0.5),
        'c_w_ukv': nrm(ks[14], (DEPTH, C_KV_LORA, C_HEADS * (C_NOPE + C_V_DIM)), C_KV_LORA ** -0.5),
        'c_q_norm': gain(ks[15], (DEPTH, C_NOPE + C_ROPE)),
        'c_k_norm': gain(ks[16], (DEPTH, C_NOPE + C_ROPE)),
        'd_w_group': nrm(ks[17], (DEPTH, D_GROUPS, D_GROUP_DIM, D_GROUP_DIM), D_GROUP_DIM ** -0.5),
        'd_scale': gain(ks[18], (DEPTH, BRANCH_W)),
    }


def reference(x, meta_tokens, norm_w, w_in, w_out, a_q_norm, a_k_norm, a_lambda, a_subln, b_q_norm, b_k_norm,
              c_q_lat_norm, c_kv_lat_norm, c_w_uq, c_w_ukv, c_q_norm, c_k_norm, d_w_group, d_scale):
    b, n_tok, d = x.shape
    rows = n_tok // GRID_W
    l = N_META + n_tok
    h = jnp.concatenate([jnp.broadcast_to(meta_tokens[None].astype(x.dtype), (b, N_META, d)), x], axis=1)

    pos = jnp.arange(l, dtype=jnp.int32)
    cos_a, sin_a = rope_table(pos, A_ROT, ROPE_THETA)
    cos_m, sin_m = rope_table(pos, C_ROPE, ROPE_THETA)
    row_pos = jnp.concatenate([jnp.full((N_META,), -1, jnp.int32),
                               jnp.repeat(jnp.arange(rows, dtype=jnp.int32), GRID_W)])
    col_pos = jnp.concatenate([jnp.arange(N_META, dtype=jnp.int32),
                               jnp.tile(jnp.arange(GRID_W, dtype=jnp.int32), rows)])
    cos_r, sin_r = rope_table(row_pos, B_HEAD_DIM // 2, AXIAL_THETA)
    cos_c, sin_c = rope_table(col_pos, B_HEAD_DIM // 2, AXIAL_THETA)
    tabs = (cos_a, sin_a, cos_r, sin_r, cos_c, sin_c, cos_m, sin_m)

    for i in range(DEPTH):
        lambda_init = 0.8 - 0.6 * math.exp(-0.3 * i)
        h = hybrid_layer(h, norm_w[i], w_in[i], w_out[i], a_q_norm[i], a_k_norm[i], a_lambda[i], a_subln[i],
                         b_q_norm[i], b_k_norm[i], c_q_lat_norm[i], c_kv_lat_norm[i], c_w_uq[i], c_w_ukv[i],
                         c_q_norm[i], c_k_norm[i], d_w_group[i], d_scale[i], lambda_init, tabs)
    return h[:, N_META:]
```

```cpp
#include <hip/hip_runtime.h>
#include <hip/hip_cooperative_groups.h>
#include <hip/hip_bf16.h>
#include <cstdio>
#include <cstdint>
#include <cmath>
namespace cg = cooperative_groups;
__device__ __forceinline__ int lane_id_v() { int l; asm volatile("v_mbcnt_lo_u32_b32 %0, -1, 0\n\tv_mbcnt_hi_u32_b32 %0, -1, %0" : "=v"(l)); return l; }
#define TIDX ((int)((wave_s << 6) | lane_id_v()))

namespace pg8 {
#define PG8_LAS __attribute__((address_space(3)))
typedef unsigned short bf16_t;
typedef short bf16x8 __attribute__((ext_vector_type(8)));
typedef float f32x4 __attribute__((ext_vector_type(4)));
typedef unsigned u32x4 __attribute__((ext_vector_type(4)));
constexpr int BM = 256, BK = 64, HALF = 128, HTB = HALF * BK * 2  , STAGE_BYTES = 8 * HTB, NXCD = 8, WGM = 8;

__host__ __device__ __forceinline__ int lds_byte(int r, int c) { const int st = (r >> 4) * 2 + (c >> 5), rr = r & 15, cc = c & 31, ob = rr * 64 + cc * 2; return st * 1024 + (ob ^ (((ob >> 9) & 1) << 5)); }
__host__ __device__ __forceinline__ void stage_rc(int b, int& R, int& C) { const int st = b / 1024, sb = b % 1024, swz = sb ^ (((sb >> 9) & 1) << 5); R = (st >> 1) * 16 + swz / 64; C = (st & 1) * 32 + (swz % 64) / 2; }
__host__ __device__ __forceinline__ int perm32(int rho) { const int n = rho >> 4, i = rho & 15; return 8 * (i >> 2) + 4 * n + (i & 3); }

struct Unit { int pm, pn; };
struct Gemm { const bf16_t* A; const bf16_t* Bt; int M, N, K, lda; };

struct StaticOrder {
    int nM, nN, nwg, G, c;
    __host__ __device__ void init(int M, int N, int G_, int c_) { nM = M / BM; nN = N / BM; nwg = nM * nN; G = G_; c = c_; }
    __host__ __device__ bool next(int i, Unit& u) const {
        const long L = (long)i * G + c; if (L >= nwg) return false;
        int wgid = (int)L; { const int q = nwg / NXCD, r = nwg % NXCD, xcd = wgid % NXCD, off = wgid / NXCD; wgid = (xcd < r ? xcd * (q + 1) : r * (q + 1) + (xcd - r) * q) + off; }
        const int nig = WGM * nN, gid = wgid / nig, fm = gid * WGM, gsz = (nM - fm) < WGM ? (nM - fm) : WGM;
        u.pm = fm + ((wgid % nig) % gsz); u.pn = (wgid % nig) / gsz; return true;
    }
    __device__ __forceinline__ void a_ready(const Unit&) const {}
    __device__ __forceinline__ void done(const Unit&) const {}
};

__device__ __forceinline__ unsigned cvt_pk_bf16(float lo, float hi) { unsigned r; asm volatile("v_cvt_pk_bf16_f32 %0, %1, %2" : "=v"(r) : "v"(lo), "v"(hi)); return r; }

struct EpiBf16 {
    static constexpr bool PERM = true, AFTER_DRAIN = false;
    bf16_t* O; int ldc;
    __device__ __forceinline__ void operator()(const f32x4 (&acc)[2][2][4][2], const Unit& u, int wr, int wc, int fr, int fq) const {
        const int row0 = u.pm * BM + wr * 64 + fr; const int col0 = u.pn * BM + wc * 32 + 8 * fq;
#pragma unroll
        for (int ai = 0; ai < 2; ++ai)
#pragma unroll
            for (int m = 0; m < 4; ++m) { bf16_t* rowp = O + (size_t)(row0 + ai * HALF + m * 16) * ldc + col0;
#pragma unroll
                for (int bj = 0; bj < 2; ++bj) { const f32x4 v0 = acc[ai][bj][m][0], v1 = acc[ai][bj][m][1];
                    u32x4 w; w.x = cvt_pk_bf16(v0[0], v0[1]); w.y = cvt_pk_bf16(v0[2], v0[3]); w.z = cvt_pk_bf16(v1[0], v1[1]); w.w = cvt_pk_bf16(v1[2], v1[3]);
                    *(u32x4*)(rowp + bj * HALF) = w; } }
    }
};
struct EpiRes {
    static constexpr bool PERM = false, AFTER_DRAIN = false;
    const float* res_meta; const float* res_body; float* out_meta; float* out_body; int ldc, nmeta, lrows;
    __device__ __forceinline__ void operator()(const f32x4 (&acc)[2][2][4][2], const Unit& u, int wr, int wc, int fr, int fq) const {
        const int row0 = u.pm * BM + wr * 64 + fr; const int col0 = u.pn * BM + wc * 32 + 4 * fq;
#pragma unroll
        for (int ai = 0; ai < 2; ++ai)
#pragma unroll
            for (int m = 0; m < 4; ++m) { const int r = row0 + ai * HALF + m * 16;
                if (r < lrows) {
                    const float* rp = (r < nmeta) ? res_meta + (size_t)r * ldc : res_body + (size_t)(r - nmeta) * ldc;
                    float* op = (r < nmeta) ? out_meta : out_body;
                    if (op) { op += (r < nmeta) ? (size_t)r * ldc : (size_t)(r - nmeta) * ldc;
#pragma unroll
                    for (int bj = 0; bj < 2; ++bj)
#pragma unroll
                        for (int n = 0; n < 2; ++n) { const int c = col0 + bj * HALF + n * 16; const f32x4 b = *(const f32x4*)(rp + c); *(f32x4*)(op + c) = b + acc[ai][bj][m][n]; } } } }
    }
};

template <class Epi, class Sched, bool ALIGN_EPI = false, bool SP2 = false>
__device__ __forceinline__ void gemm_phase(PG8_LAS unsigned char* lds, const Gemm g, const Sched& S, const Epi& E, const int wave_s) {
    int tid_ = TIDX; asm volatile("" : "+v"(tid_));
    const int tid = tid_, wid = __builtin_amdgcn_readfirstlane(tid >> 6), lane = tid & 63, wr = wid >> 2, wc = wid & 3, fr = lane & 15, fq = lane >> 4;
    const int K = g.K, nt = K / BK;
    unsigned voffA[2], voffB[2];
#pragma unroll
    for (int i = 0; i < 2; ++i) { int R, C; stage_rc(tid * 16 + i * 8192, R, C); const int Rb = Epi::PERM ? ((R & ~31) + perm32(R & 31)) : R;
        voffA[i] = (unsigned)(R * g.lda + C) * 2u; voffB[i] = (unsigned)(Rb * K + C) * 2u; }
    const size_t kstep = (size_t)(BK * 2);
    const size_t hstep = (size_t)HALF * K * 2;
    const size_t tstep = 2 * hstep; const size_t hstepA = (size_t)HALF * g.lda * 2, tstepA = 2 * hstepA;
    const unsigned ldsw = (unsigned)wid * 1024u;
    const int aoff = lds_byte(wr * 64 + fr, fq * 8), boff = lds_byte(wc * 32 + fr, fq * 8);
#define PG8_SA(b, h) (((b) * 2 + (h)) * HTB)
#define PG8_SB(b, h) ((4 + (b) * 2 + (h)) * HTB)
#define PG8_STAGE(bufoff, gbase, voff) do { _Pragma("unroll") for (int _i = 0; _i < 2; ++_i) \
        __builtin_amdgcn_global_load_lds((const unsigned*)((const char*)(gbase) + (voff)[_i]), (PG8_LAS unsigned*)(lds + (bufoff) + ldsw + _i * 8192), 16, 0, 0); } while (0)
#define PG8_LDA(dst, b, h) do { _Pragma("unroll") for (int m = 0; m < 4; ++m) _Pragma("unroll") for (int k = 0; k < 2; ++k) dst[m][k] = *(const PG8_LAS bf16x8*)(lds + PG8_SA(b, h) + aoff + m * 2048 + k * 1024); } while (0)
#define PG8_LDB(dst, b, h) do { _Pragma("unroll") for (int n = 0; n < 2; ++n) _Pragma("unroll") for (int k = 0; k < 2; ++k) dst[n][k] = *(const PG8_LAS bf16x8*)(lds + PG8_SB(b, h) + boff + n * 2048 + k * 1024); } while (0)
#define PG8_MMA(ai, bj, At, Bt) do { __builtin_amdgcn_s_setprio(1); _Pragma("unroll") for (int m = 0; m < 4; ++m) _Pragma("unroll") for (int n = 0; n < 2; ++n) _Pragma("unroll") for (int k = 0; k < 2; ++k) \
        acc[ai][bj][m][n] = __builtin_amdgcn_mfma_f32_16x16x32_bf16(Bt[n][k], At[m][k], acc[ai][bj][m][n], 0, 0, 0); __builtin_amdgcn_s_setprio(0); } while (0)
#define PG8_WAIT_V(n) asm volatile("s_waitcnt vmcnt(" #n ")" ::: "memory")
#define PG8_WAIT_L(n) asm volatile("s_waitcnt lgkmcnt(" #n ")" ::: "memory")
#define PG8_BAR __builtin_amdgcn_s_barrier()
#define PG8_SCHED __builtin_amdgcn_sched_barrier(0)
    Unit cur, nxt; int ui = 0;
    if (!S.next(0, cur)) return;
    f32x4 acc[2][2][4][2];
#pragma unroll
    for (int a = 0; a < 2; ++a)
#pragma unroll
        for (int b = 0; b < 2; ++b)
#pragma unroll
            for (int m = 0; m < 4; ++m)
#pragma unroll
                for (int n = 0; n < 2; ++n) acc[a][b][m][n] = (f32x4){0.f, 0.f, 0.f, 0.f};
    bf16x8 At[4][2], B0[2][2], B1[2][2];
    const char* cA = (const char*)g.A + (size_t)cur.pm * tstepA; const char* cB = (const char*)g.Bt + (size_t)cur.pn * tstep;
    S.a_ready(cur);
    if constexpr (SP2) {
        PG8_STAGE(PG8_SB(0, 0), cB, voffB); PG8_STAGE(PG8_SB(0, 1), cB + hstep, voffB); PG8_STAGE(PG8_SA(0, 0), cA, voffA); PG8_STAGE(PG8_SA(0, 1), cA + hstepA, voffA);
        if (wr == 1) PG8_BAR;
        PG8_WAIT_V(2); PG8_BAR;
        PG8_STAGE(PG8_SB(1, 0), cB + kstep, voffB); PG8_STAGE(PG8_SA(1, 0), cA + kstep, voffA); PG8_STAGE(PG8_SB(1, 1), cB + hstep + kstep, voffB);
        PG8_WAIT_V(6); PG8_BAR;
    } else {
        PG8_STAGE(PG8_SB(0, 0), cB, voffB); PG8_STAGE(PG8_SA(0, 0), cA, voffA); PG8_STAGE(PG8_SB(0, 1), cB + hstep, voffB); PG8_STAGE(PG8_SA(0, 1), cA + hstepA, voffA);
        if (wr == 1) PG8_BAR;
        PG8_WAIT_V(4); PG8_BAR;
        PG8_STAGE(PG8_SB(1, 0), cB + kstep, voffB); PG8_STAGE(PG8_SA(1, 0), cA + kstep, voffA); PG8_STAGE(PG8_SB(1, 1), cB + hstep + kstep, voffB);
        PG8_WAIT_V(6); PG8_BAR;
    }
    for (;;) {
        const bool has_next = S.next(ui + 1, nxt);
        const char* nA = has_next ? (const char*)g.A + (size_t)nxt.pm * tstepA : cA; const char* nB = has_next ? (const char*)g.Bt + (size_t)nxt.pn * tstep : cB;
        for (int t = 0; t < nt; t += 2) {
            const bool last = (t == nt - 2);
            const char* a1 = cA + (size_t)(t + 1) * kstep;
            const char* a2 = last ? nA : cA + (size_t)(t + 2) * kstep; const char* b2 = last ? nB : cB + (size_t)(t + 2) * kstep;
            const char* a3 = a2 + kstep; const char* b3 = b2 + kstep;
            if (last && has_next) S.a_ready(nxt);
            if constexpr (SP2) {
            PG8_LDB(B0, 0, 0); PG8_LDB(B1, 0, 1); PG8_SCHED; PG8_LDA(At, 0, 0); PG8_STAGE(PG8_SA(1, 1), a1 + hstepA, voffA);
            PG8_WAIT_V(8); PG8_WAIT_L(0); PG8_BAR; PG8_MMA(0, 0, At, B0); PG8_MMA(0, 1, At, B1); PG8_BAR; PG8_SCHED;
            PG8_LDA(At, 0, 1); PG8_STAGE(PG8_SB(0, 0), b2, voffB); PG8_STAGE(PG8_SB(0, 1), b2 + hstep, voffB); PG8_STAGE(PG8_SA(0, 0), a2, voffA);
            PG8_WAIT_V(8); PG8_WAIT_L(0); PG8_BAR; PG8_MMA(1, 0, At, B0); PG8_MMA(1, 1, At, B1); PG8_BAR; PG8_SCHED;
            PG8_LDB(B0, 1, 0); PG8_LDB(B1, 1, 1); PG8_SCHED; PG8_LDA(At, 1, 0); PG8_STAGE(PG8_SA(0, 1), a2 + hstepA, voffA);
            PG8_WAIT_V(8); PG8_WAIT_L(0); PG8_BAR; PG8_MMA(0, 0, At, B0); PG8_MMA(0, 1, At, B1); PG8_BAR; PG8_SCHED;
            PG8_LDA(At, 1, 1); PG8_STAGE(PG8_SB(1, 0), b3, voffB); PG8_STAGE(PG8_SB(1, 1), b3 + hstep, voffB); PG8_STAGE(PG8_SA(1, 0), a3, voffA);
            PG8_WAIT_V(8); PG8_WAIT_L(0); PG8_BAR; PG8_MMA(1, 0, At, B0); PG8_MMA(1, 1, At, B1); PG8_BAR; PG8_SCHED;
            } else {
            PG8_LDB(B0, 0, 0); PG8_SCHED; PG8_LDA(At, 0, 0); PG8_STAGE(PG8_SA(1, 1), a1 + hstepA, voffA);
            PG8_WAIT_L(8); PG8_BAR; PG8_WAIT_L(0); PG8_MMA(0, 0, At, B0); PG8_BAR; PG8_SCHED;
            PG8_LDB(B1, 0, 1); PG8_STAGE(PG8_SB(0, 0), b2, voffB);
            PG8_BAR; PG8_WAIT_L(0); PG8_MMA(0, 1, At, B1); PG8_BAR;
            PG8_LDA(At, 0, 1); PG8_STAGE(PG8_SA(0, 0), a2, voffA);
            PG8_BAR; PG8_WAIT_L(0); PG8_MMA(1, 0, At, B0); PG8_BAR; PG8_SCHED;
            PG8_STAGE(PG8_SB(0, 1), b2 + hstep, voffB);
            PG8_WAIT_V(6); PG8_BAR; PG8_MMA(1, 1, At, B1); PG8_BAR;
            PG8_LDB(B0, 1, 0); PG8_SCHED; PG8_LDA(At, 1, 0); PG8_STAGE(PG8_SA(0, 1), a2 + hstepA, voffA);
            PG8_WAIT_L(8); PG8_BAR; PG8_WAIT_L(0); PG8_MMA(0, 0, At, B0); PG8_BAR; PG8_SCHED;
            PG8_LDB(B1, 1, 1); PG8_STAGE(PG8_SB(1, 0), b3, voffB);
            PG8_BAR; PG8_WAIT_L(0); PG8_MMA(0, 1, At, B1); PG8_BAR;
            PG8_LDA(At, 1, 1); PG8_STAGE(PG8_SA(1, 0), a3, voffA);
            PG8_BAR; PG8_WAIT_L(0); PG8_MMA(1, 0, At, B0); PG8_BAR; PG8_SCHED;
            PG8_STAGE(PG8_SB(1, 1), b3 + hstep, voffB);
            PG8_WAIT_V(6); PG8_BAR; PG8_MMA(1, 1, At, B1); PG8_BAR;
            }
        }
        if constexpr (ALIGN_EPI) { if (wr == 0) PG8_BAR; }
        if constexpr (!Epi::AFTER_DRAIN) { E(acc, cur, wr, wc, fr, fq); S.done(cur); }
        if (!has_next) break;
#pragma unroll
        for (int a = 0; a < 2; ++a)
#pragma unroll
            for (int b = 0; b < 2; ++b)
#pragma unroll
                for (int m = 0; m < 4; ++m)
#pragma unroll
                    for (int n = 0; n < 2; ++n) acc[a][b][m][n] = (f32x4){0.f, 0.f, 0.f, 0.f};
        cur = nxt; cA = nA; cB = nB; ++ui;
        if constexpr (ALIGN_EPI) { if (wr == 1) PG8_BAR; }
    }
    PG8_WAIT_V(0);
    if constexpr (!ALIGN_EPI) { if (wr == 0) PG8_BAR; }
    PG8_BAR;
    if constexpr (Epi::AFTER_DRAIN) { E.fused(acc, cur, wr, wc, fr, fq, lds, wid, lane); S.done(cur); }
#undef PG8_SA
#undef PG8_SB
#undef PG8_STAGE
#undef PG8_LDA
#undef PG8_LDB
#undef PG8_MMA
#undef PG8_WAIT_V
#undef PG8_WAIT_L
#undef PG8_BAR
#undef PG8_SCHED
}
}

#ifndef ATT_KPRELOAD
#define ATT_KPRELOAD 1
#endif
#ifndef ATT_KEARLY
#define ATT_KEARLY 1
#endif
#ifndef ATT_STEP_VPIPE
#define ATT_STEP_VPIPE 1
#endif
#ifndef ATT_STEP
#define ATT_STEP 0
#endif
namespace att {
using bf16 = unsigned short;
using bf16x8 = __attribute__((ext_vector_type(8))) short;
using s16x4  = __attribute__((ext_vector_type(4))) short;
using f32x16 = __attribute__((ext_vector_type(16))) float;
using u32x4  = __attribute__((ext_vector_type(4))) unsigned;
constexpr int NW = 8, QBLK = 32, KVBLK = 64;
constexpr int LROWS = 16400;
constexpr int NT = 257;
constexpr float THR = 8.f;
constexpr int SHM_V = KVBLK * 128 * 2;
constexpr int K_OFF = 4 * SHM_V, WS_OFF = K_OFF + 4 * KVBLK * 128 * 2, ATT_LDS = WS_OFF + NW * 64 * 4;
static_assert(2 * KVBLK * 192 * 2 <= 4 * KVBLK * 128 * 2, "K region");
#define SBAR() __builtin_amdgcn_sched_barrier(0)
__device__ __forceinline__ int crow(int r, int hi) { return (r & 3) + 8 * (r >> 2) + 4 * hi; }
__device__ __forceinline__ unsigned cvtpk(float lo, float hi) { unsigned r; asm volatile("v_cvt_pk_bf16_f32 %0, %1, %2" : "=v"(r) : "v"(lo), "v"(hi)); return r; }
__device__ __forceinline__ bf16x8 ld8(const bf16* p) { return *reinterpret_cast<const bf16x8*>(p); }

template <bool FIXM>
__device__ __forceinline__ void partialSM(f32x16& p0, f32x16& p1, float& m_reg, float& mn, float& alpha, const float C, const float thrS, const int kb, const int hi) {
  if constexpr (FIXM) {
#pragma unroll
    for (int r = 0; r < 16; ++r) p0[r] = __builtin_amdgcn_exp2f(p0[r]);
    if (kb + KVBLK > LROWS) {
#pragma unroll
      for (int r = 0; r < 16; ++r) { if (kb + crow(r, hi) >= LROWS) p0[r] = 0.f; }
    }
    return;
  }
  if (kb + KVBLK > LROWS) {
#pragma unroll
    for (int r = 0; r < 16; ++r) { const int k0 = kb + crow(r, hi); if (k0 >= LROWS) p0[r] = -1e30f; if (k0 + 32 >= LROWS) p1[r] = -1e30f; }
  }
  float pmax = p0[0];
#pragma unroll
  for (int r = 1; r < 16; ++r) pmax = fmaxf(pmax, p0[r]);
#pragma unroll
  for (int r = 0; r < 16; ++r) pmax = fmaxf(pmax, p1[r]);
  { auto rr = __builtin_amdgcn_permlane32_swap(__float_as_uint(pmax), __float_as_uint(pmax), false, false);
    pmax = fmaxf(__uint_as_float(rr[0]), __uint_as_float(rr[1])); }
  if (__builtin_expect(__all(pmax - m_reg <= thrS), 1)) { mn = m_reg; alpha = 1.f; }
  else { mn = fmaxf(m_reg, pmax); alpha = __builtin_amdgcn_exp2f((m_reg - mn) * C); m_reg = mn; }
  const float mnC = -mn * C;
#pragma unroll
  for (int r = 0; r < 16; ++r) p0[r] = fmaf(p0[r], C, mnC);
#pragma unroll
  for (int r = 0; r < 16; ++r) p1[r] = fmaf(p1[r], C, mnC);
#pragma unroll
  for (int r = 0; r < 16; ++r) p0[r] = __builtin_amdgcn_exp2f(p0[r]);
}
template <bool FIXM>
__device__ __forceinline__ void finishSM(f32x16& p0, f32x16& p1, float alpha, float& l_reg, bf16x8& pa0, bf16x8& pa1, bf16x8& pa2, bf16x8& pa3, const int kb, const int hi) {
#pragma unroll
  for (int r = 0; r < 16; ++r) p1[r] = __builtin_amdgcn_exp2f(p1[r]);
  if constexpr (FIXM) { if (kb + KVBLK > LROWS) {
#pragma unroll
    for (int r = 0; r < 16; ++r) { if (kb + 32 + crow(r, hi) >= LROWS) p1[r] = 0.f; } } }
  float ps = 0;
#pragma unroll
  for (int r = 0; r < 16; ++r) ps += p0[r];
#pragma unroll
  for (int r = 0; r < 16; ++r) ps += p1[r];
  if constexpr (FIXM) l_reg += ps; else l_reg = l_reg * alpha + ps;
#define PK4(P, BASE, OUT) do { unsigned a0 = cvtpk(P[BASE + 0], P[BASE + 1]), a1 = cvtpk(P[BASE + 2], P[BASE + 3]);   \
    unsigned b0 = cvtpk(P[BASE + 4], P[BASE + 5]), b1 = cvtpk(P[BASE + 6], P[BASE + 7]);                              \
    u32x4 w = {a0, a1, b0, b1}; OUT = *reinterpret_cast<bf16x8*>(&w); } while (0)
  PK4(p0, 0, pa0); PK4(p0, 8, pa1); PK4(p1, 0, pa2); PK4(p1, 8, pa3);
#undef PK4
}
#define KSWZ(KP, row, colB) ((row) * (KP) + ((colB) ^ ((KP) == 256 ? (((row) & 15) << 4) : ((((row) >> 1) & 7) << 4))))
template <int DQK>
__device__ __forceinline__ void qkt(f32x16& p0, f32x16& p1, const char* Ks, const bf16x8* qr, int r32, int hi) {
  constexpr int KP = DQK * 2;
  p0 = f32x16{}; p1 = f32x16{};
  if constexpr (DQK == 64 && ATT_KPRELOAD) {
    bf16x8 ka[4], kq[4];
#pragma unroll
    for (int d0 = 0; d0 < 4; ++d0) { const int cb = (d0 * 16 + hi * 8) * 2;
      ka[d0] = *reinterpret_cast<const bf16x8*>(Ks + KSWZ(KP, r32, cb)); kq[d0] = *reinterpret_cast<const bf16x8*>(Ks + KSWZ(KP, 32 + r32, cb)); }
    SBAR();
#pragma unroll
    for (int d0 = 0; d0 < 4; ++d0) { p0 = __builtin_amdgcn_mfma_f32_32x32x16_bf16(ka[d0], qr[d0], p0, 0, 0, 0); p1 = __builtin_amdgcn_mfma_f32_32x32x16_bf16(kq[d0], qr[d0], p1, 0, 0, 0); }
    return;
  }
#pragma unroll
  for (int d0 = 0; d0 < DQK / 16; ++d0) { const int cb = (d0 * 16 + hi * 8) * 2;
    bf16x8 b0 = *reinterpret_cast<const bf16x8*>(Ks + KSWZ(KP, r32, cb));
    bf16x8 b1 = *reinterpret_cast<const bf16x8*>(Ks + KSWZ(KP, 32 + r32, cb));
    p0 = __builtin_amdgcn_mfma_f32_32x32x16_bf16(b0, qr[d0], p0, 0, 0, 0);
    p1 = __builtin_amdgcn_mfma_f32_32x32x16_bf16(b1, qr[d0], p1, 0, 0, 0); }
}
__device__ __forceinline__ int v_st(int k, int c) { const int kk = k; return ((kk >> 3) * 4 + (c >> 5)) * 512 + ((kk & 7) * 32 + (c & 31)) * 2; }
__device__ __forceinline__ int v_rd_base(int lane) { return ((lane & 3) << 3) | (((lane >> 2) & 3) << 6) | (((lane >> 4) & 1) << 5) | (((lane >> 5) & 1) << 8); }
constexpr int v_rd_off(int d0, int ks, int half) { return d0 * 512 + ks * 4096 + half * 2048; }
template <int OFF> __device__ __forceinline__ s16x4 tr_read(int vb) {
  s16x4 r; asm volatile("ds_read_b64_tr_b16 %0, %1 offset:%2" : "=&v"(r) : "v"(vb), "i"(OFF) : "memory"); return r;
}
template <int D0> __device__ __forceinline__ void pv_one(f32x16& od, int vb, bf16x8 pa0, bf16x8 pa1, bf16x8 pa2, bf16x8 pa3) {
  const s16x4 l0 = tr_read<v_rd_off(D0, 0, 0)>(vb), h0 = tr_read<v_rd_off(D0, 0, 1)>(vb), l1 = tr_read<v_rd_off(D0, 1, 0)>(vb), h1 = tr_read<v_rd_off(D0, 1, 1)>(vb);
  const s16x4 l2 = tr_read<v_rd_off(D0, 2, 0)>(vb), h2 = tr_read<v_rd_off(D0, 2, 1)>(vb), l3 = tr_read<v_rd_off(D0, 3, 0)>(vb), h3 = tr_read<v_rd_off(D0, 3, 1)>(vb);
  asm volatile("s_waitcnt lgkmcnt(0)" ::: "memory"); SBAR();
#define PK(L, H) (bf16x8){L[0], L[1], L[2], L[3], H[0], H[1], H[2], H[3]}
  od = __builtin_amdgcn_mfma_f32_32x32x16_bf16(pa0, PK(l0, h0), od, 0, 0, 0);
  od = __builtin_amdgcn_mfma_f32_32x32x16_bf16(pa1, PK(l1, h1), od, 0, 0, 0);
  od = __builtin_amdgcn_mfma_f32_32x32x16_bf16(pa2, PK(l2, h2), od, 0, 0, 0);
  od = __builtin_amdgcn_mfma_f32_32x32x16_bf16(pa3, PK(l3, h3), od, 0, 0, 0);
#undef PK
}
__device__ __forceinline__ void pv_d0(f32x16* o, int vb, bf16x8 pa0, bf16x8 pa1, bf16x8 pa2, bf16x8 pa3) {
  pv_one<0>(o[0], vb, pa0, pa1, pa2, pa3); pv_one<1>(o[1], vb, pa0, pa1, pa2, pa3); pv_one<2>(o[2], vb, pa0, pa1, pa2, pa3); pv_one<3>(o[3], vb, pa0, pa1, pa2, pa3);
}
__device__ __forceinline__ float bf2f(unsigned short b) { return __uint_as_float((unsigned)b << 16); }
__device__ __forceinline__ unsigned f2bf(float f) { unsigned u = __float_as_uint(f); return (u + 0x7fffu + ((u >> 16) & 1u)) >> 16; }
struct VF { s16x4 l0, h0, l1, h1, l2, h2, l3, h3; };
template <int D0> __device__ __forceinline__ void v_issue(VF& f, int vb) {
  f.l0 = tr_read<v_rd_off(D0, 0, 0)>(vb); f.h0 = tr_read<v_rd_off(D0, 0, 1)>(vb); f.l1 = tr_read<v_rd_off(D0, 1, 0)>(vb); f.h1 = tr_read<v_rd_off(D0, 1, 1)>(vb);
  f.l2 = tr_read<v_rd_off(D0, 2, 0)>(vb); f.h2 = tr_read<v_rd_off(D0, 2, 1)>(vb); f.l3 = tr_read<v_rd_off(D0, 3, 0)>(vb); f.h3 = tr_read<v_rd_off(D0, 3, 1)>(vb);
}
__device__ __forceinline__ void pv_mma(f32x16& od, const VF& f, bf16x8 pa0, bf16x8 pa1, bf16x8 pa2, bf16x8 pa3) {
#define PK(L, H) (bf16x8){L[0], L[1], L[2], L[3], H[0], H[1], H[2], H[3]}
  od = __builtin_amdgcn_mfma_f32_32x32x16_bf16(pa0, PK(f.l0, f.h0), od, 0, 0, 0);
  od = __builtin_amdgcn_mfma_f32_32x32x16_bf16(pa1, PK(f.l1, f.h1), od, 0, 0, 0);
  od = __builtin_amdgcn_mfma_f32_32x32x16_bf16(pa2, PK(f.l2, f.h2), od, 0, 0, 0);
  od = __builtin_amdgcn_mfma_f32_32x32x16_bf16(pa3, PK(f.l3, f.h3), od, 0, 0, 0);
#undef PK
}
__device__ __forceinline__ void pv_pipe(f32x16* o, int vb, VF& f0, VF& f1, bf16x8 pa0, bf16x8 pa1, bf16x8 pa2, bf16x8 pa3) {
  v_issue<1>(f1, vb); asm volatile("s_waitcnt lgkmcnt(8)" ::: "memory"); SBAR(); pv_mma(o[0], f0, pa0, pa1, pa2, pa3); SBAR();
  v_issue<2>(f0, vb); asm volatile("s_waitcnt lgkmcnt(8)" ::: "memory"); SBAR(); pv_mma(o[1], f1, pa0, pa1, pa2, pa3); SBAR();
  v_issue<3>(f1, vb); asm volatile("s_waitcnt lgkmcnt(8)" ::: "memory"); SBAR(); pv_mma(o[2], f0, pa0, pa1, pa2, pa3); SBAR();
  asm volatile("s_waitcnt lgkmcnt(0)" ::: "memory"); SBAR(); pv_mma(o[3], f1, pa0, pa1, pa2, pa3);
}

template <int DQK, int SDEPTH, int MODE, int PIPE, int ldq, int ldk, int ldv, int ldo, int ldy, int ldg, bool SPLIT = false, bool FIXM = false, bool KVT2 = false>
__device__ __forceinline__ void attn_unit(const int wave_s, const bf16* __restrict__ Qb, const bf16* __restrict__ Kh, const bf16* __restrict__ Vh,
                                          const float scale, const int nvalid, float* __restrict__ Of, bf16* __restrict__ Yb,
                                          const bf16* __restrict__ Gb, char* lds, const int kb0_ = 0, const int nt_ = NT, float* __restrict__ part = nullptr) {
  const int kb0 = SPLIT ? kb0_ : 0, nt = SPLIT ? nt_ : NT;
  Kh += (long)kb0 * ldk; Vh += (long)kb0 * ldv;
  constexpr int ND0 = DQK / 16, KP = DQK * 2, SHM_K = KVBLK * KP, KPT = DQK / 64, NKP = DQK / 8;
  int tid_ = TIDX; asm volatile("" : "+v"(tid_));
  const int tid = tid_, wid = tid >> 6, lane = tid & 63, r32 = lane & 31, hi = lane >> 5;
  char* V_lds = lds; char* K_lds = lds + K_OFF;
  float* ws = (float*)(lds + WS_OFF) + wid * 64; float* li_l = ws; float* al_l = ws + 32;
  const float C = scale * 1.4426950408889634f, thrS = THR / scale;
  float m_reg = -1e30f, l_reg = 0; f32x16 o[4] = {}; bf16x8 qr[ND0];
  const bf16* Qw = Qb + (long)(wid * QBLK + r32) * ldq + hi * 8;
#pragma unroll
  for (int d0 = 0; d0 < ND0; ++d0) qr[d0] = ld8(Qw + d0 * 16);
  const int sr = tid >> 4, sc = (tid & 15) * 8, vst0 = v_st(sr, sc), vst1 = v_st(32 + sr, sc);
  const int vg0 = sr * ldv + sc, vg1 = (32 + sr) * ldv + sc;
  int kst[KPT], kg[KPT];
#pragma unroll
  for (int i = 0; i < KPT; ++i) { const int p = tid + 512 * i, row = p / NKP, cp = p % NKP; kst[i] = KSWZ(KP, row, cp * 16); kg[i] = row * ldk + cp * 8; }
  const int vb0 = (int)(uintptr_t)V_lds + v_rd_base(lane);
  struct { bf16x8 vs0, vs1, ks[KPT]; } sr_[SDEPTH];
  const __amdgpu_buffer_rsrc_t rsK = __builtin_amdgcn_make_buffer_rsrc((void*)Kh, 0, 0x7fffffff, 0x00020000);
  const __amdgpu_buffer_rsrc_t rsV = __builtin_amdgcn_make_buffer_rsrc((void*)Vh, 0, 0x7fffffff, 0x00020000);
#define BLD(rs, voff, soff) __builtin_bit_cast(bf16x8, __builtin_amdgcn_raw_buffer_load_b128((rs), (voff), (soff), 0))
#define SLOAD(i, k0) do { const int sv_ = (k0) * (ldv * 2), sk_ = (k0) * (ldk * 2); sr_[i].vs0 = BLD(rsV, vg0 * 2, sv_); sr_[i].vs1 = BLD(rsV, vg1 * 2, sv_); \
    _Pragma("unroll") for (int q_ = 0; q_ < KPT; ++q_) sr_[i].ks[q_] = BLD(rsK, kg[q_] * 2, sk_); } while (0)
#define SWRITE(b, i) do { *(bf16x8*)(V_lds + (b) * SHM_V + vst0) = sr_[i].vs0; *(bf16x8*)(V_lds + (b) * SHM_V + vst1) = sr_[i].vs1; \
    _Pragma("unroll") for (int q_ = 0; q_ < KPT; ++q_) *(bf16x8*)(K_lds + (b) * SHM_K + kst[q_]) = sr_[i].ks[q_]; } while (0)
#define SWAIT() do { if constexpr (SDEPTH == 2) { if constexpr (KPT == 1) asm volatile("s_waitcnt vmcnt(3)" ::: "memory"); else if constexpr (KPT == 2) asm volatile("s_waitcnt vmcnt(4)" ::: "memory"); else asm volatile("s_waitcnt vmcnt(5)" ::: "memory"); } \
    else asm volatile("s_waitcnt vmcnt(0)" ::: "memory"); } while (0)
#define RESC(a) do { if constexpr (!FIXM) if (__any((a) < 1.f)) { if (hi == 0) al_l[r32] = (a); asm volatile("s_waitcnt lgkmcnt(0)" ::: "memory"); \
    _Pragma("unroll") for (int d = 0; d < 4; ++d) _Pragma("unroll") for (int r = 0; r < 16; ++r) o[d][r] *= al_l[crow(r, hi)]; } } while (0)
  f32x16 pA0, pA1, pB0, pB1; float mnA, mnB, alA, alB; bf16x8 pa0, pa1, pa2, pa3;
  if constexpr (PIPE == 0 && KVT2) {
    static_assert(SDEPTH == 2 && DQK <= 128, "double tiles need two staging slots and fit LDS only for DQK <= 128");
    const int nd = nt >> 1;
    SLOAD(0, 0); SLOAD(1, KVBLK); asm volatile("s_waitcnt vmcnt(0)" ::: "memory"); SWRITE(0, 0); SWRITE(1, 1); SLOAD(0, 2 * KVBLK); SLOAD(1, 3 * KVBLK);
    for (int jj = 0; jj < nd; ++jj) {
      const int b = jj & 1;
      __syncthreads();
      if (jj + 1 < nd) { SWRITE(2 * (b ^ 1), 0); SWRITE(2 * (b ^ 1) + 1, 1); }
      if (jj + 2 < nd) { SLOAD(0, (2 * jj + 4) * KVBLK); SLOAD(1, (2 * jj + 5) * KVBLK); }
#pragma unroll
      for (int sub = 0; sub < 2; ++sub) {
        const int sb = 2 * b + sub, kb = kb0 + (2 * jj + sub) * KVBLK;
        SBAR(); qkt<DQK>(pA0, pA1, K_lds + sb * SHM_K, qr, r32, hi); SBAR();
        const int vb = vb0 + sb * SHM_V;
        VF f0, f1; v_issue<0>(f0, vb);
        partialSM<FIXM>(pA0, pA1, m_reg, mnA, alA, C, thrS, kb, hi);
        RESC(alA);
        finishSM<FIXM>(pA0, pA1, alA, l_reg, pa0, pa1, pa2, pa3, kb, hi); SBAR();
        pv_pipe(o, vb, f0, f1, pa0, pa1, pa2, pa3);
      }
    }
  } else if constexpr (PIPE == 0 && !SPLIT && ATT_STEP) {
#define SLOADK(k0) do { const bf16* kp_ = Kh + (long)(k0) * ldk; _Pragma("unroll") for (int q_ = 0; q_ < KPT; ++q_) sr_[0].ks[q_] = ld8(kp_ + kg[q_]); } while (0)
#define SLOADV(k0) do { const bf16* vp_ = Vh + (long)(k0) * ldv; sr_[0].vs0 = ld8(vp_ + vg0); sr_[0].vs1 = ld8(vp_ + vg1); } while (0)
#define SWRITEK(b) do { _Pragma("unroll") for (int q_ = 0; q_ < KPT; ++q_) *(bf16x8*)(K_lds + (b) * SHM_K + kst[q_]) = sr_[0].ks[q_]; } while (0)
#define SWRITEV(b) do { *(bf16x8*)(V_lds + (b) * SHM_V + vst0) = sr_[0].vs0; *(bf16x8*)(V_lds + (b) * SHM_V + vst1) = sr_[0].vs1; } while (0)
    SLOADK(0); SLOADV(0); asm volatile("s_waitcnt vmcnt(0)" ::: "memory"); SWRITEK(0); SWRITEV(0); SLOADK(KVBLK); SLOADV(KVBLK);
    if (wave_s >= 4) __syncthreads();
    for (int j = 0; j < nt; ++j) {
      const int b = j & 1;
      __syncthreads();
      if (j + 1 < nt) { SWRITEK(b ^ 1); }
      if (j + 2 < nt) { SLOADK((j + 2) * KVBLK); }
      SBAR(); qkt<DQK>(pA0, pA1, K_lds + b * SHM_K, qr, r32, hi); SBAR();
      __syncthreads();
      if (j + 1 < nt) { SWRITEV(b ^ 1); }
      if (j + 2 < nt) { SLOADV((j + 2) * KVBLK); }
      { const int vb = vb0 + b * SHM_V, kb = kb0 + j * KVBLK;
        if constexpr (DQK != 192 && ATT_STEP_VPIPE) {
          VF f0, f1; v_issue<0>(f0, vb);
          partialSM<FIXM>(pA0, pA1, m_reg, mnA, alA, C, thrS, kb, hi); RESC(alA);
          finishSM<FIXM>(pA0, pA1, alA, l_reg, pa0, pa1, pa2, pa3, kb, hi); SBAR();
          pv_pipe(o, vb, f0, f1, pa0, pa1, pa2, pa3);
        } else {
          partialSM<FIXM>(pA0, pA1, m_reg, mnA, alA, C, thrS, kb, hi); RESC(alA);
          finishSM<FIXM>(pA0, pA1, alA, l_reg, pa0, pa1, pa2, pa3, kb, hi); SBAR();
          pv_d0(o, vb, pa0, pa1, pa2, pa3);
        } }
    }
    if (wave_s < 4) __syncthreads();
#undef SLOADK
#undef SLOADV
#undef SWRITEK
#undef SWRITEV
  } else if constexpr (PIPE == 0) {
    SLOAD(0, 0); asm volatile("s_waitcnt vmcnt(0)" ::: "memory"); SWRITE(0, 0); SLOAD(0, KVBLK);
    for (int j = 0; j < nt; ++j) {
      const int b = j & 1;
      __syncthreads();
      if constexpr (DQK == 64 && ATT_KEARLY) {
        bf16x8 ka[4], kq[4]; const char* Ks = K_lds + b * SHM_K;
#pragma unroll
        for (int d0 = 0; d0 < 4; ++d0) { const int cb = (d0 * 16 + hi * 8) * 2;
          ka[d0] = *reinterpret_cast<const bf16x8*>(Ks + KSWZ(KP, r32, cb)); kq[d0] = *reinterpret_cast<const bf16x8*>(Ks + KSWZ(KP, 32 + r32, cb)); }
        SBAR();
        if (j + 1 < nt) { SWRITE(b ^ 1, 0); }
        if (j + 2 < nt) { SLOAD(0, (j + 2) * KVBLK); }
        SBAR();
        pA0 = f32x16{}; pA1 = f32x16{};
#pragma unroll
        for (int d0 = 0; d0 < 4; ++d0) { pA0 = __builtin_amdgcn_mfma_f32_32x32x16_bf16(ka[d0], qr[d0], pA0, 0, 0, 0); pA1 = __builtin_amdgcn_mfma_f32_32x32x16_bf16(kq[d0], qr[d0], pA1, 0, 0, 0); }
        SBAR();
      } else {
      if (j + 1 < nt) { SWRITE(b ^ 1, 0); }
      if (j + 2 < nt) { SLOAD(0, (j + 2) * KVBLK); }
      SBAR(); qkt<DQK>(pA0, pA1, K_lds + b * SHM_K, qr, r32, hi); SBAR();
      }
      const int vb = vb0 + b * SHM_V;
      if constexpr (DQK != 192) {
        VF f0, f1; v_issue<0>(f0, vb);
        partialSM<FIXM>(pA0, pA1, m_reg, mnA, alA, C, thrS, kb0 + j * KVBLK, hi);
        RESC(alA);
        finishSM<FIXM>(pA0, pA1, alA, l_reg, pa0, pa1, pa2, pa3, kb0 + j * KVBLK, hi); SBAR();
        pv_pipe(o, vb, f0, f1, pa0, pa1, pa2, pa3);
      } else {
        partialSM<FIXM>(pA0, pA1, m_reg, mnA, alA, C, thrS, kb0 + j * KVBLK, hi);
        RESC(alA);
        finishSM<FIXM>(pA0, pA1, alA, l_reg, pa0, pa1, pa2, pa3, kb0 + j * KVBLK, hi); SBAR();
        pv_d0(o, vb, pa0, pa1, pa2, pa3);
      }
    }
  } else {
  constexpr int SE = 0, SO = SDEPTH - 1;
  SLOAD(SE, 0); asm volatile("s_waitcnt vmcnt(0)" ::: "memory"); SWRITE(0, SE); __syncthreads();
  qkt<DQK>(pA0, pA1, K_lds, qr, r32, hi); partialSM<FIXM>(pA0, pA1, m_reg, mnA, alA, C, thrS, kb0, hi);
  SLOAD(SO, KVBLK); if constexpr (SDEPTH == 2) { SLOAD(SE, 2 * KVBLK); }
  SWAIT(); SWRITE(1, SO); __syncthreads();
  for (int j = 1; j + 1 < nt; j += 2) {
    SBAR(); qkt<DQK>(pB0, pB1, K_lds + SHM_K, qr, r32, hi);
    finishSM<FIXM>(pA0, pA1, alA, l_reg, pa0, pa1, pa2, pa3, kb0 + (j - 1) * KVBLK, hi); SBAR();
    SLOAD(SO, (j + SDEPTH) * KVBLK); SBAR();
    pv_d0(o, vb0, pa0, pa1, pa2, pa3); partialSM<FIXM>(pB0, pB1, m_reg, mnB, alB, C, thrS, kb0 + j * KVBLK, hi);
    __syncthreads(); SWAIT(); SWRITE(0, SE);
    RESC(alB); __syncthreads();
    SBAR(); qkt<DQK>(pA0, pA1, K_lds, qr, r32, hi);
    finishSM<FIXM>(pB0, pB1, alB, l_reg, pa0, pa1, pa2, pa3, kb0 + j * KVBLK, hi); SBAR();
    if (SDEPTH == 1 || j + 3 < nt) SLOAD(SE, (j + 1 + SDEPTH) * KVBLK); SBAR();
    pv_d0(o, vb0 + SHM_V, pa0, pa1, pa2, pa3); partialSM<FIXM>(pA0, pA1, m_reg, mnA, alA, C, thrS, kb0 + (j + 1) * KVBLK, hi);
    __syncthreads(); SWAIT(); SWRITE(1, SO);
    RESC(alA); __syncthreads();
  }
  SBAR(); qkt<DQK>(pB0, pB1, K_lds + SHM_K, qr, r32, hi);
  finishSM<FIXM>(pA0, pA1, alA, l_reg, pa0, pa1, pa2, pa3, kb0 + (nt - 2) * KVBLK, hi); SBAR();
  pv_d0(o, vb0, pa0, pa1, pa2, pa3); partialSM<FIXM>(pB0, pB1, m_reg, mnB, alB, C, thrS, kb0 + (nt - 1) * KVBLK, hi);
  __syncthreads(); RESC(alB);
  finishSM<FIXM>(pB0, pB1, alB, l_reg, pa0, pa1, pa2, pa3, kb0 + (nt - 1) * KVBLK, hi); SBAR();
  pv_d0(o, vb0 + SHM_V, pa0, pa1, pa2, pa3);
  }
  { auto rr = __builtin_amdgcn_permlane32_swap(__float_as_uint(l_reg), __float_as_uint(l_reg), false, false);
    l_reg = __uint_as_float(rr[0]) + __uint_as_float(rr[1]); }
  if constexpr (SPLIT) if (part != nullptr) {
    if (wid == 0) {
#pragma unroll
      for (int r = 0; r < 16; ++r) { const int orow = crow(r, hi);
        if (orow < 16) {
#pragma unroll
          for (int d0 = 0; d0 < 4; ++d0) part[orow * 132 + d0 * 32 + r32] = o[d0][r]; } }
      if (hi == 0 && r32 < 16) { part[r32 * 132 + 128] = m_reg; part[r32 * 132 + 129] = l_reg; }
    }
    __syncthreads();
    return;
  }
  if (hi == 0) li_l[r32] = l_reg; asm volatile("s_waitcnt lgkmcnt(0)" ::: "memory");
#pragma unroll
  for (int r = 0; r < 16; ++r) { const int orow = wid * QBLK + crow(r, hi); const float rli = __builtin_amdgcn_rcpf(li_l[crow(r, hi)]);
    if (orow < nvalid) {
      if constexpr (MODE == 0) {
#pragma unroll
        for (int d0 = 0; d0 < 4; ++d0) Of[(long)orow * ldo + d0 * 32 + r32] = o[d0][r] * rli;
      } else {
#pragma unroll
        for (int d0 = 0; d0 < 4; ++d0) { const float g = bf2f(Gb[(long)orow * ldg + d0 * 32 + r32]); const float sg = g / (1.f + __expf(-g));
          Yb[(long)orow * ldy + d0 * 32 + r32] = (bf16)f2bf(o[d0][r] * rli * sg); }
      }
    } }
  __syncthreads();
#undef SLOAD
#undef SWRITE
#undef SWAIT
#undef RESC
}
}

#define LAS __attribute__((address_space(3)))
typedef unsigned short bf16_t;
typedef float f32x4 __attribute__((ext_vector_type(4)));
typedef unsigned u32x4 __attribute__((ext_vector_type(4)));
typedef unsigned u32x2 __attribute__((ext_vector_type(2)));
constexpr int DM = 2048, SEQ = 16384, NMETA = 16, LROWS = SEQ + NMETA, MP = 16640  , DEPTH = 2;
constexpr int INC = 5824, INP = 5888;
constexpr float EPS = 1e-6f;
constexpr int C_AQ = 0, C_AK = 512, C_AV = 1024, C_AG = 1536, C_BQ = 2048, C_BK = 2560, C_BV = 2816, C_BG = 3072,
              C_CQ = 3584, C_CKV = 3968, C_CKR = 4224, C_CG = 4288, C_DU = 4800, C_DG = 5312;
constexpr size_t MiB = 1u << 20;
constexpr size_t al256(size_t x) { return (x + 255) / 256 * 256; }
constexpr size_t WS_CTL = 0;
constexpr size_t WS_XMETA = 4096;
constexpr size_t WS_BAR = 256 * 1024;
constexpr size_t WS_PART = 512 * 1024;
constexpr size_t WS_WIN = 2 * MiB;
constexpr size_t WS_WOUT = WS_WIN + al256((size_t)DEPTH * INP * DM * 2);
constexpr size_t WS_WUQ = WS_WOUT + al256((size_t)DEPTH * DM * DM * 2);
constexpr size_t WS_WUKV = WS_WUQ + al256((size_t)DEPTH * 768 * 384 * 2);
constexpr size_t WS_WD = WS_WUKV + al256((size_t)DEPTH * 1024 * 256 * 2);
constexpr size_t WS_HY = WS_WD + al256((size_t)DEPTH * 512 * 512 * 2);
constexpr size_t WS_P = WS_HY + al256((size_t)MP * DM * 2);
constexpr size_t WS_POOL = WS_P + al256((size_t)MP * INP * 2);
constexpr size_t WS_QC = WS_POOL + al256((size_t)MP * 512 * 2);
constexpr size_t WS_KVC = WS_QC + al256((size_t)MP * 768 * 2);
constexpr size_t WS_KC = WS_KVC + al256((size_t)MP * 1024 * 2);
constexpr size_t WS_OA = WS_KC + al256((size_t)MP * 768 * 2);
constexpr size_t WS_END = WS_OA + al256((size_t)MP * 1024 * 4);

constexpr float LOG2E = 1.4426950408889634f, LN2 = 0.6931471805599453f;
constexpr float QS_A = 0.125f * LOG2E, QS_B = 0.08838834764831845f * LOG2E, QS_C = 0.07216878364870323f * LOG2E;
struct Params {
  const float *x, *meta, *norm_w, *w_in, *w_out, *a_q_norm, *a_k_norm, *a_lambda, *a_subln, *b_q_norm, *b_k_norm,
              *c_q_lat, *c_kv_lat, *c_w_uq, *c_w_ukv, *c_q_norm, *c_k_norm, *d_w_group, *d_scale;
  float* out; unsigned char* ws;
  float inv_a[8], inv_b[32], inv_c[32];
};

__device__ __forceinline__ float bf2f(unsigned short b) { return __uint_as_float((unsigned)b << 16); }
__device__ __forceinline__ float bflo(unsigned w) { return __uint_as_float(w << 16); }
__device__ __forceinline__ float bfhi(unsigned w) { return __uint_as_float(w & 0xffff0000u); }
__device__ __forceinline__ unsigned f2bf(float f) { unsigned u = __float_as_uint(f); return (u + 0x7fffu + ((u >> 16) & 1u)) >> 16; }
__device__ __forceinline__ unsigned pk2(float lo, float hi) { return f2bf(lo) | (f2bf(hi) << 16); }
__device__ __forceinline__ float silu(float g) { return g / (1.f + __expf(-g)); }
__device__ __forceinline__ float wave_sum(float v) {
#pragma unroll
  for (int o = 1; o < 64; o <<= 1) v += __shfl_xor(v, o);
  return v;
}
__device__ __forceinline__ float wave_max(float v) {
#pragma unroll
  for (int o = 1; o < 64; o <<= 1) v = fmaxf(v, __shfl_xor(v, o));
  return v;
}
__device__ __forceinline__ float sum16(float v) { v += __shfl_xor(v, 1); v += __shfl_xor(v, 2); v += __shfl_xor(v, 4); v += __shfl_xor(v, 8); return v; }
__device__ __forceinline__ void rope_cs(float pos, float inv, float& c, float& s) {
  const float ang = pos * inv;
  double rev = (double)ang * 0.15915494309189535; rev -= rint(rev);
  const float fr = (float)rev;
  s = __builtin_amdgcn_sinf(fr); c = __builtin_amdgcn_cosf(fr);
}
__device__ __forceinline__ void unpack8(const u32x4 w, float* x) { x[0] = bflo(w.x); x[1] = bfhi(w.x); x[2] = bflo(w.y); x[3] = bfhi(w.y); x[4] = bflo(w.z); x[5] = bfhi(w.z); x[6] = bflo(w.w); x[7] = bfhi(w.w); }
__device__ __forceinline__ u32x4 pack8(const float* x) { u32x4 w; w.x = pk2(x[0], x[1]); w.y = pk2(x[2], x[3]); w.z = pk2(x[4], x[5]); w.w = pk2(x[6], x[7]); return w; }

#define XB_TMO      128
#define XB_XCNT(j)  (256  + 64 * (j))
#define XB_XSUB(j)  (1280 + 64 * (j))
#define XB_XGEN(j)  (2304 + 64 * (j))
#define XB_TOP      3328
#define XB_TOPGEN   3392
#define XCD_BAR_WORDS 3456
#define XB_SPIN_CAP (1u << 18)

__device__ __forceinline__ unsigned xb_ld(unsigned* p)              { return __hip_atomic_load(p, __ATOMIC_RELAXED, __HIP_MEMORY_SCOPE_AGENT); }
__device__ __forceinline__ unsigned xb_add(unsigned* p, unsigned v) { return __hip_atomic_fetch_add(p, v, __ATOMIC_RELAXED, __HIP_MEMORY_SCOPE_AGENT); }
__device__ __forceinline__ unsigned xb_xcc_id() { return (unsigned)__builtin_amdgcn_s_getreg((3 << 11) | 20) & 0xFu; }
#define XB_SPIN(cond, bar) do { unsigned _sp = 0; while (cond) { __builtin_amdgcn_s_sleep(1); \
    if ((++_sp & 255u) == 0u) { if (xb_ld(&(bar)[XB_TMO])) break; if (_sp > XB_SPIN_CAP) { atomicAdd(&(bar)[XB_TMO], 1u); break; } } } } while (0)

struct XcdBarrier {
    unsigned* bar; unsigned x;
    volatile LAS unsigned* st;
};

__device__ __forceinline__ XcdBarrier xcd_barrier_post(unsigned* bar, volatile LAS unsigned* st, const int wave_s) {
    XcdBarrier b; b.bar = bar; b.x = xb_xcc_id(); b.st = st;
    if (TIDX == 0) (void)xb_add(&bar[XB_XCNT(b.x)], 1u);
    return b;
}
__device__ __forceinline__ void xcd_barrier_complete(unsigned* bar, unsigned x, unsigned& nloc, unsigned& nx) {
    const unsigned G = gridDim.x * gridDim.y * gridDim.z;
    unsigned sum, cnt, mine, sp = 0u;
    for (;;) {
        sum = 0u; cnt = 0u; mine = 0u;
#pragma unroll
        for (unsigned j = 0; j < 16; ++j) { const unsigned c = xb_ld(&bar[XB_XCNT(j)]); sum += c; cnt += (c > 0u) ? 1u : 0u; mine = (j == x) ? c : mine; }
        if (sum == G) break;
        __builtin_amdgcn_s_sleep(1);
        if ((++sp & 255u) == 0u) { if (xb_ld(&bar[XB_TMO])) break; if (sp > XB_SPIN_CAP) { atomicAdd(&bar[XB_TMO], 1u); break; } }
    }
    nloc = mine > 0u ? mine : 1u; nx = cnt > 0u ? cnt : 1u;
}

__device__ __forceinline__ void xcd_barrier(const XcdBarrier& b, const int wave_s) {
    asm volatile("s_waitcnt vmcnt(0)" ::: "memory");
    __syncthreads();
    if (TIDX == 0) {
        unsigned* bar = b.bar;
        __builtin_amdgcn_s_waitcnt(0);
        unsigned nloc = b.st[0], nx = b.st[1];
        if (nloc == 0u) { xcd_barrier_complete(bar, b.x, nloc, nx); b.st[0] = nloc; b.st[1] = nx; }
        const unsigned old = xb_add(&bar[XB_XSUB(b.x)], 1u);
        const unsigned gen = old / nloc;
        if (old + 1u == (gen + 1u) * nloc) {
            __builtin_amdgcn_fence(__ATOMIC_RELEASE, "agent");
            asm volatile("s_waitcnt vmcnt(0)" ::: "memory");
            const unsigned og = xb_add(&bar[XB_TOP], 1u);
            const unsigned tg = og / nx;
            if (og + 1u == (tg + 1u) * nx) xb_add(&bar[XB_TOPGEN], 1u);
            else XB_SPIN(xb_ld(&bar[XB_TOPGEN]) == tg, bar);
            __builtin_amdgcn_fence(__ATOMIC_ACQUIRE, "agent");
            xb_add(&bar[XB_XGEN(b.x)], 1u);
            asm volatile("s_waitcnt vmcnt(0)" ::: "memory");
        } else {
            XB_SPIN(xb_ld(&bar[XB_XGEN(b.x)]) == gen, bar);
            __builtin_amdgcn_fence(__ATOMIC_ACQUIRE, "agent");
            asm volatile("s_waitcnt vmcnt(0)" ::: "memory");
        }
    }
    __syncthreads();
}

__device__ __forceinline__ void tr_item(const float* __restrict__ W, int ldw, int sk0, int sn0, bf16_t* __restrict__ WT, int ldt, int dn0, int dk0, LAS float* scr, int lane, bool zero) {
  if (!zero) {
#pragma unroll 8
    for (int i = 0; i < 32; ++i) { const int kk = 2 * i + (lane >> 5); scr[kk * 33 + (lane & 31)] = W[(size_t)(sk0 + kk) * ldw + sn0 + (lane & 31)]; }
  }
  asm volatile("s_waitcnt lgkmcnt(0)" ::: "memory");
  const int c = lane & 7;
#pragma unroll
  for (int j = 0; j < 4; ++j) { const int n = (lane >> 3) + 8 * j; const LAS float* s = scr + (8 * c) * 33 + n;
    u32x4 o = {0u, 0u, 0u, 0u};
    if (!zero) { o.x = pk2(s[0 * 33], s[1 * 33]); o.y = pk2(s[2 * 33], s[3 * 33]); o.z = pk2(s[4 * 33], s[5 * 33]); o.w = pk2(s[6 * 33], s[7 * 33]); }
    *(u32x4*)(WT + (size_t)(dn0 + n) * ldt + dk0 + 8 * c) = o; }
  asm volatile("s_waitcnt lgkmcnt(0)" ::: "memory");
}

__device__ __forceinline__ void phase_prologue(const Params& p, LAS unsigned char* lds, const int wave_s) {
  int t_ = TIDX; asm volatile("" : "+v"(t_)); const int lane = t_ & 63, wave = __builtin_amdgcn_readfirstlane(t_ >> 6), gw = blockIdx.x * 8 + wave, NGW = gridDim.x * 8; (void)wave;
  LAS float* scr = (LAS float*)(lds + wave * 16384);
  unsigned char* ws = p.ws;
  constexpr int I_IN = (DM / 64) * (INC / 32), I_OUT = (DM / 64) * (DM / 32), I_UQ = (384 / 64) * (768 / 32), I_UKV = (256 / 64) * (1024 / 32), I_D = (512 / 64) * (512 / 32);
  constexpr int I_LAYER = I_IN + I_OUT + I_UQ + I_UKV + I_D;
  for (int it = gw; it < DEPTH * I_LAYER; it += NGW) {
    const int layer = it / I_LAYER; int r = it % I_LAYER;
    if (r < I_IN) { const int nblk = INC / 32, kb = r / nblk, nb = r % nblk;
      tr_item(p.w_in + (size_t)layer * DM * INC, INC, 64 * kb, 32 * nb, (bf16_t*)(ws + WS_WIN) + (size_t)layer * INP * DM, DM, 32 * nb, 64 * kb, scr, lane, false); continue; } r -= I_IN;
    if (r < I_OUT) { const int nblk = DM / 32, kb = r / nblk, nb = r % nblk;
      tr_item(p.w_out + (size_t)layer * DM * DM, DM, 64 * kb, 32 * nb, (bf16_t*)(ws + WS_WOUT) + (size_t)layer * DM * DM, DM, 32 * nb, 64 * kb, scr, lane, false); continue; } r -= I_OUT;
    if (r < I_UQ) { const int nblk = 768 / 32, kb = r / nblk, nb = r % nblk;
      tr_item(p.c_w_uq + (size_t)layer * 384 * 768, 768, 64 * kb, 32 * nb, (bf16_t*)(ws + WS_WUQ) + (size_t)layer * 768 * 384, 384, 32 * nb, 64 * kb, scr, lane, false); continue; } r -= I_UQ;
    if (r < I_UKV) { const int nblk = 1024 / 32, kb = r / nblk, nb = r % nblk;
      tr_item(p.c_w_ukv + (size_t)layer * 256 * 1024, 1024, 64 * kb, 32 * nb, (bf16_t*)(ws + WS_WUKV) + (size_t)layer * 1024 * 256, 256, 32 * nb, 64 * kb, scr, lane, false); continue; } r -= I_UKV;
    { const int nblk = 512 / 32, kb = r / nblk, nb = r % nblk, k0 = 64 * kb, n0 = 32 * nb, gk = k0 >> 7, gn = n0 >> 7;
      tr_item(p.d_w_group + ((size_t)layer * 4 + gk) * 128 * 128, 128, k0 & 127, n0 & 127, (bf16_t*)(ws + WS_WD) + (size_t)layer * 512 * 512, 512, n0, k0, scr, lane, gk != gn); }
  }
  for (int i = gw * 64 + lane; i < DEPTH * (INP - INC) * DM / 8; i += NGW * 64) { const int layer = i / ((INP - INC) * DM / 8), j = i % ((INP - INC) * DM / 8);
    *(u32x4*)((bf16_t*)(ws + WS_WIN) + (size_t)layer * INP * DM + (size_t)INC * DM + (size_t)j * 8) = (u32x4){0u, 0u, 0u, 0u}; }
  if (gw == 0) { ((unsigned*)(ws + WS_CTL))[lane] = 0u; ((unsigned*)(ws + WS_CTL))[64 + lane] = 0u; }
  if (gw < DEPTH) { const int layer = gw, ln = lane; int fastmask;
    const float* aqn = p.a_q_norm + layer * 64; const float* akn = p.a_k_norm + layer * 64; const float* bqn = p.b_q_norm + layer * 128; const float* bkn = p.b_k_norm + layer * 128;
    const float* cqn = p.c_q_norm + layer * 192; const float* ckn = p.c_k_norm + layer * 192;
    const float maq = wave_max(fabsf(aqn[ln])), mak = wave_max(fabsf(akn[ln]));
    const float mbq = wave_max(fmaxf(fabsf(bqn[ln]), fabsf(bqn[64 + ln]))), mbk = wave_max(fmaxf(fabsf(bkn[ln]), fabsf(bkn[64 + ln])));
    const float mcqn = wave_max(fmaxf(fabsf(cqn[ln]), fabsf(cqn[64 + ln]))), mcqr = wave_max(fabsf(cqn[128 + ln]));
    const float mckn = wave_max(fmaxf(fabsf(ckn[ln]), fabsf(ckn[64 + ln]))), mckr = wave_max(fabsf(ckn[128 + ln]));
    const float bA = 64.f * maq * mak * QS_A, bB = 128.f * mbq * mbk * QS_B;
    const float bC = sqrtf((128.f * mcqn * mcqn + 64.f * mcqr * mcqr) * (128.f * mckn * mckn + 64.f * mckr * mckr)) * QS_C;
    fastmask = (bC < 60.f ? 1 : 0) | (bB < 60.f ? 2 : 0) | (bA < 60.f ? 4 : 0);
    if (lane == 0) ((int*)(ws + WS_CTL))[256 + layer] = fastmask; }

  if (blockIdx.x == 0) { for (int i = t_; i < XCD_BAR_WORDS; i += 512) ((unsigned*)(ws + WS_BAR))[i] = 0u; }
}

__device__ __forceinline__ void phase_rmsnorm(const float* __restrict__ src_meta, const float* __restrict__ src_body, const float* __restrict__ w, bf16_t* __restrict__ H, const int wave_s) {
  int t_ = TIDX; asm volatile("" : "+v"(t_)); const int lane = t_ & 63, wave = __builtin_amdgcn_readfirstlane(t_ >> 6), gw = blockIdx.x * 8 + wave, NGW = gridDim.x * 8; (void)wave;
  f32x4 g[8], v[8], nx[8];
#pragma unroll
  for (int j = 0; j < 8; ++j) g[j] = ((const f32x4*)w)[lane + 64 * j];
#define RMS_LOAD(dst, rr) do { const float* row_ = ((rr) < NMETA) ? src_meta + (size_t)(rr) * DM : src_body + (size_t)((rr) - NMETA) * DM; const f32x4* xr_ = (const f32x4*)row_ + lane; \
    _Pragma("unroll") for (int j = 0; j < 8; ++j) dst[j] = xr_[64 * j]; } while (0)
  if (gw < LROWS) RMS_LOAD(v, gw);
  for (int r = gw; r < LROWS; r += NGW) {
    const int rn = r + NGW;
    if (rn < LROWS) RMS_LOAD(nx, rn);
    float ss = 0.f;
#pragma unroll
    for (int j = 0; j < 8; ++j) ss += (v[j].x * v[j].x + v[j].y * v[j].y) + (v[j].z * v[j].z + v[j].w * v[j].w);
    const float rs = rsqrtf(wave_sum(ss) * (1.f / DM) + EPS);
    u32x2* o8 = (u32x2*)(H + (size_t)r * DM) + lane;
#pragma unroll
    for (int j = 0; j < 8; ++j) o8[64 * j] = (u32x2){pk2(v[j].x * rs * g[j].x, v[j].y * rs * g[j].y), pk2(v[j].z * rs * g[j].z, v[j].w * rs * g[j].w)};
#pragma unroll
    for (int j = 0; j < 8; ++j) v[j] = nx[j];
  }
#undef RMS_LOAD
  for (int r = LROWS + gw; r < MP; r += NGW) {
    u32x2* o8 = (u32x2*)(H + (size_t)r * DM) + lane;
#pragma unroll
    for (int j = 0; j < 8; ++j) o8[64 * j] = (u32x2){0u, 0u};
  }
}

__device__ __forceinline__ void phase_post1(const Params& p, int layer, const int wave_s) {
  int t_ = TIDX; asm volatile("" : "+v"(t_)); const int lane = t_ & 63, wave = __builtin_amdgcn_readfirstlane(t_ >> 6), gw = blockIdx.x * 8 + wave, NGW = gridDim.x * 8; (void)wave;
  bf16_t* P = (bf16_t*)(p.ws + WS_P); bf16_t* POOL = (bf16_t*)(p.ws + WS_POOL); bf16_t* KC = (bf16_t*)(p.ws + WS_KC);
  const float* aqn = p.a_q_norm + layer * 64; const float* akn = p.a_k_norm + layer * 64;
  const float* bqn = p.b_q_norm + layer * 128; const float* bkn = p.b_k_norm + layer * 128;
  const float* cql = p.c_q_lat + layer * 384; const float* ckvl = p.c_kv_lat + layer * 256; const float* ckn = p.c_k_norm + layer * 192;
  for (int r = gw; r < MP; r += NGW) {
    if (r >= LROWS) {
      *(u32x4*)(POOL + (size_t)r * 512 + lane * 8) = (u32x4){0u, 0u, 0u, 0u};
      for (int i = lane; i < 768 / 8; i += 64) *(u32x4*)(KC + (size_t)r * 768 + i * 8) = (u32x4){0u, 0u, 0u, 0u};
      continue; }
    bf16_t* pr = P + (size_t)r * INP;
    const float posf = (float)r;
    const float rowp = (r < NMETA) ? -1.f : (float)((r - NMETA) >> 6), colp = (r < NMETA) ? (float)r : (float)((r - NMETA) & 63);
    { float x[16]; u32x4* ptr = (u32x4*)(pr + C_AQ + lane * 16); const u32x4 w0 = ptr[0], w1 = ptr[1]; unpack8(w0, x); unpack8(w1, x + 8);
      float ss = 0.f;
#pragma unroll
      for (int i = 0; i < 16; ++i) ss += x[i] * x[i];
      ss += __shfl_xor(ss, 1); ss += __shfl_xor(ss, 2);
      const float rs = rsqrtf(ss * (1.f / 64.f) + EPS) * ((lane >> 5) ? 1.f : QS_A);
      const float* wn = ((lane >> 5) ? akn : aqn) + (lane & 3) * 16;
#pragma unroll
      for (int i = 0; i < 16; ++i) x[i] = x[i] * rs * wn[i];
      if ((lane & 3) == 0) {
#pragma unroll
        for (int j = 0; j < 8; ++j) { float c, s; rope_cs(posf, p.inv_a[j], c, s); const float x1 = x[j], x2 = x[8 + j]; x[j] = x1 * c - x2 * s; x[8 + j] = x1 * s + x2 * c; }
      }
      ptr[0] = pack8(x); ptr[1] = pack8(x + 8); }
#pragma unroll
    for (int pass = 0; pass < 2; ++pass) {
      const bool act = (pass == 0) || (lane < 32);
      u32x4* ptr = (u32x4*)(pr + (pass == 0 ? C_BQ : C_BK) + lane * 8);
      float x[8]; u32x4 w = {0u, 0u, 0u, 0u}; if (act) w = *ptr; unpack8(w, x);
      float ss = 0.f;
#pragma unroll
      for (int i = 0; i < 8; ++i) ss += x[i] * x[i];
      ss = sum16(ss);
      const float rs = rsqrtf(ss * (1.f / 128.f) + EPS) * (pass == 0 ? QS_B : 1.f);
      const int a = lane & 15; const float* wn = (pass == 0 ? bqn : bkn) + a * 8;
      const float posv = (a < 8) ? rowp : colp;
#pragma unroll
      for (int i = 0; i < 8; ++i) { const float y = x[i] * rs * wn[i]; const float other = __shfl_xor(y, 4);
        float c, s; rope_cs(posv, p.inv_b[(a & 3) * 8 + i], c, s);
        x[i] = (a & 4) ? other * s + y * c : y * c - other * s; }
      if (act) *ptr = pack8(x);
    }
    { unsigned* ptr = (unsigned*)(pr + C_CQ); unsigned w[3]; float ss = 0.f;
#pragma unroll
      for (int j = 0; j < 3; ++j) { w[j] = ptr[lane + 64 * j]; const float a = bflo(w[j]), b = bfhi(w[j]); ss += a * a + b * b; }
      const float rs = rsqrtf(wave_sum(ss) * (1.f / 384.f) + EPS);
#pragma unroll
      for (int j = 0; j < 3; ++j) { const int e = 2 * (lane + 64 * j); ptr[lane + 64 * j] = pk2(bflo(w[j]) * rs * cql[e], bfhi(w[j]) * rs * cql[e + 1]); } }
    { u32x2* ptr = (u32x2*)(pr + C_CKV) + lane; const u32x2 w = *ptr; const float a0 = bflo(w.x), a1 = bfhi(w.x), a2 = bflo(w.y), a3 = bfhi(w.y);
      const float rs = rsqrtf(wave_sum(a0 * a0 + a1 * a1 + a2 * a2 + a3 * a3) * (1.f / 256.f) + EPS);
      const float* g = ckvl + lane * 4;
      *ptr = (u32x2){pk2(a0 * rs * g[0], a1 * rs * g[1]), pk2(a2 * rs * g[2], a3 * rs * g[3])}; }
    { const float xk = bf2f(pr[C_CKR + lane]); const float rs = rsqrtf(wave_sum(xk * xk) * (1.f / 64.f) + EPS);
      const float y = xk * rs * ckn[128 + lane]; const float other = __shfl_xor(y, 32);
      float c, s; rope_cs(posf, p.inv_c[lane & 31], c, s);
      const float o = (lane & 32) ? other * s + y * c : y * c - other * s; const bf16_t ob = (bf16_t)f2bf(o);
#pragma unroll
      for (int h = 0; h < 4; ++h) KC[(size_t)r * 768 + h * 192 + 128 + lane] = ob; }
    { const int hw = 1 << (lane >> 4); const int lo = max(r - hw, 0), hi = min(r + hw, LROWS);
      float acc[8], u[8];
#pragma unroll
      for (int i = 0; i < 8; ++i) acc[i] = 0.f;
      u32x4 wv[16];
#pragma unroll
      for (int j = 0; j < 16; ++j) { const int t = min(max(r - 8 + j, 0), LROWS - 1); wv[j] = *(const u32x4*)(P + (size_t)t * INP + C_DU + lane * 8); }
#pragma unroll
      for (int j = 0; j < 16; ++j) { const int t = r - 8 + j; float x[8]; unpack8(wv[j], x); const bool in = (t >= lo) && (t < hi);
#pragma unroll
        for (int i = 0; i < 8; ++i) acc[i] += in ? x[i] : 0.f;
        if (j == 8) {
#pragma unroll
          for (int i = 0; i < 8; ++i) u[i] = x[i]; } }
      const float inv = 1.f / (float)(hi - lo);
#pragma unroll
      for (int i = 0; i < 8; ++i) acc[i] = acc[i] * inv - u[i];
      *(u32x4*)(POOL + (size_t)r * 512 + lane * 8) = pack8(acc); }
  }
}

__device__ __forceinline__ void phase_post2(const Params& p, int layer, const int wave_s) {
  int t_ = TIDX; asm volatile("" : "+v"(t_)); const int lane = t_ & 63, wave = __builtin_amdgcn_readfirstlane(t_ >> 6), gw = blockIdx.x * 8 + wave, NGW = gridDim.x * 8; (void)wave;
  bf16_t* QC = (bf16_t*)(p.ws + WS_QC); const bf16_t* KVC = (const bf16_t*)(p.ws + WS_KVC); bf16_t* KC = (bf16_t*)(p.ws + WS_KC);
  const float* cqn = p.c_q_norm + layer * 192; const float* ckn = p.c_k_norm + layer * 192;
  const int h = lane >> 4, a = lane & 15;
  for (int r = gw; r < LROWS; r += NGW) {
    const float posf = (float)r;
    { u32x4* ptr = (u32x4*)(QC + (size_t)r * 768 + h * 192 + a * 8); float x[8]; unpack8(*ptr, x); float ss = 0.f;
#pragma unroll
      for (int i = 0; i < 8; ++i) ss += x[i] * x[i];
      const float rs = rsqrtf(sum16(ss) * (1.f / 128.f) + EPS) * QS_C;
#pragma unroll
      for (int i = 0; i < 8; ++i) x[i] = x[i] * rs * cqn[a * 8 + i];
      *ptr = pack8(x); }
    { u32x2* ptr = (u32x2*)(QC + (size_t)r * 768 + h * 192 + 128 + a * 4); const u32x2 w = *ptr; float x[4] = {bflo(w.x), bfhi(w.x), bflo(w.y), bfhi(w.y)};
      const float rs = rsqrtf(sum16(x[0] * x[0] + x[1] * x[1] + x[2] * x[2] + x[3] * x[3]) * (1.f / 64.f) + EPS) * QS_C;
#pragma unroll
      for (int i = 0; i < 4; ++i) { const float y = x[i] * rs * cqn[128 + a * 4 + i]; const float other = __shfl_xor(y, 8);
        float c, s; rope_cs(posf, p.inv_c[(a & 7) * 4 + i], c, s);
        x[i] = (a & 8) ? other * s + y * c : y * c - other * s; }
      *ptr = (u32x2){pk2(x[0], x[1]), pk2(x[2], x[3])}; }
    { float x[8]; unpack8(*(const u32x4*)(KVC + (size_t)r * 1024 + h * 256 + a * 8), x); float ss = 0.f;
#pragma unroll
      for (int i = 0; i < 8; ++i) ss += x[i] * x[i];
      const float rs = rsqrtf(sum16(ss) * (1.f / 128.f) + EPS);
#pragma unroll
      for (int i = 0; i < 8; ++i) x[i] = x[i] * rs * ckn[a * 8 + i];
      *(u32x4*)(KC + (size_t)r * 768 + h * 192 + a * 8) = pack8(x); }
  }
}

__device__ __forceinline__ void meta_combine8(const float* __restrict__ ph, int r, int col0, float C, float* out) {
  float M = -1e30f;
#pragma unroll
  for (int sidx = 0; sidx < 8; ++sidx) M = fmaxf(M, ph[(sidx * 16 + r) * 132 + 128]);
  float l = 0.f, acc[8];
#pragma unroll
  for (int i = 0; i < 8; ++i) acc[i] = 0.f;
#pragma unroll
  for (int sidx = 0; sidx < 8; ++sidx) { const float* pp = ph + (sidx * 16 + r) * 132; const float w = exp2f((pp[128] - M) * C); l += pp[129] * w;
    const f32x4 a = *(const f32x4*)(pp + col0), b = *(const f32x4*)(pp + col0 + 4);
    acc[0] += a.x * w; acc[1] += a.y * w; acc[2] += a.z * w; acc[3] += a.w * w; acc[4] += b.x * w; acc[5] += b.y * w; acc[6] += b.z * w; acc[7] += b.w * w; }
  const float il = 1.f / l;
#pragma unroll
  for (int i = 0; i < 8; ++i) out[i] = acc[i] * il;
}

__device__ __forceinline__ void phase_post3(const Params& p, int layer, float lambda_init, const int wave_s) {
  int t_ = TIDX; asm volatile("" : "+v"(t_)); const int lane = t_ & 63, wave = __builtin_amdgcn_readfirstlane(t_ >> 6), gw = blockIdx.x * 8 + wave, NGW = gridDim.x * 8; (void)wave;
  const bf16_t* P = (const bf16_t*)(p.ws + WS_P); const float* OA = (const float*)(p.ws + WS_OA); bf16_t* Y = (bf16_t*)(p.ws + WS_HY);
  const float* lp = p.a_lambda + layer * 256; const float* sub = p.a_subln + layer * 128; const float* dsc = p.d_scale + layer * 512;
  const float lam = __expf(wave_sum(lp[lane] * lp[64 + lane])) - __expf(wave_sum(lp[128 + lane] * lp[192 + lane])) + lambda_init;
  const float post = 1.f - lambda_init;
  const int h = lane >> 4, a = lane & 15;
  const bool metasplit = (layer != DEPTH - 1);
  const float* PART = (const float*)(p.ws + WS_PART);
  for (int r = gw; r < LROWS; r += NGW) {
    if (metasplit && r < NMETA) {
      float x1[8], x2[8];
      meta_combine8(PART + (size_t)((8 + 2 * h) * 8 * 16) * 132, r, a * 8, 1.f, x1);
      meta_combine8(PART + (size_t)((8 + 2 * h + 1) * 8 * 16) * 132, r, a * 8, 1.f, x2);
      float x[8], ss = 0.f;
#pragma unroll
      for (int i = 0; i < 8; ++i) { x[i] = x1[i] - lam * x2[i]; ss += x[i] * x[i]; }
      const float rs = rsqrtf(sum16(ss) * (1.f / 128.f) + EPS);
      float g[8]; unpack8(*(const u32x4*)(P + (size_t)r * INP + C_AG + h * 128 + a * 8), g);
#pragma unroll
      for (int i = 0; i < 8; ++i) x[i] = x[i] * rs * sub[a * 8 + i] * post * silu(g[i]);
      *(u32x4*)(Y + (size_t)r * DM + h * 128 + a * 8) = pack8(x);
      meta_combine8(PART + (size_t)((4 + h) * 8 * 16) * 132, r, a * 8, 1.f, x1);
      unpack8(*(const u32x4*)(P + (size_t)r * INP + C_BG + h * 128 + a * 8), g);
#pragma unroll
      for (int i = 0; i < 8; ++i) x1[i] *= silu(g[i]);
      *(u32x4*)(Y + (size_t)r * DM + 512 + h * 128 + a * 8) = pack8(x1);
      meta_combine8(PART + (size_t)(h * 8 * 16) * 132, r, a * 8, 1.f, x2);
      unpack8(*(const u32x4*)(P + (size_t)r * INP + C_CG + h * 128 + a * 8), g);
#pragma unroll
      for (int i = 0; i < 8; ++i) x2[i] *= silu(g[i]);
      *(u32x4*)(Y + (size_t)r * DM + 1024 + h * 128 + a * 8) = pack8(x2);
    } else
    { const f32x4* o1 = (const f32x4*)(OA + (size_t)r * 1024 + (2 * h) * 128 + a * 8); const f32x4* o2 = (const f32x4*)(OA + (size_t)r * 1024 + (2 * h + 1) * 128 + a * 8);
      const f32x4 u0 = o1[0], u1 = o1[1], v0 = o2[0], v1 = o2[1];
      float x[8] = {u0.x - lam * v0.x, u0.y - lam * v0.y, u0.z - lam * v0.z, u0.w - lam * v0.w, u1.x - lam * v1.x, u1.y - lam * v1.y, u1.z - lam * v1.z, u1.w - lam * v1.w};
      float ss = 0.f;
#pragma unroll
      for (int i = 0; i < 8; ++i) ss += x[i] * x[i];
      const float rs = rsqrtf(sum16(ss) * (1.f / 128.f) + EPS);
      float g[8]; unpack8(*(const u32x4*)(P + (size_t)r * INP + C_AG + h * 128 + a * 8), g);
#pragma unroll
      for (int i = 0; i < 8; ++i) x[i] = x[i] * rs * sub[a * 8 + i] * post * silu(g[i]);
      *(u32x4*)(Y + (size_t)r * DM + h * 128 + a * 8) = pack8(x); }
    { float m[8], g[8]; unpack8(*(const u32x4*)(P + (size_t)r * INP + C_DU + lane * 8), m); unpack8(*(const u32x4*)(P + (size_t)r * INP + C_DG + lane * 8), g);
#pragma unroll
      for (int i = 0; i < 8; ++i) m[i] = m[i] * dsc[lane * 8 + i] * silu(g[i]);
      *(u32x4*)(Y + (size_t)r * DM + 1536 + lane * 8) = pack8(m); }
  }
}

#ifndef ATT_SD128
#define ATT_SD128 1
#endif
#ifndef ATT_KVT2_A
#define ATT_KVT2_A 0
#endif
#ifndef ATT_KVT2_B
#define ATT_KVT2_B 0
#endif
#ifndef ATT_STEP_VPIPE
#define ATT_STEP_VPIPE 1
#endif
#ifndef ATT_PIPE64
#define ATT_PIPE64 0
#endif
#ifndef ATT_PIPE128
#define ATT_PIPE128 0
#endif
#ifndef ATT_SD192
#define ATT_SD192 1
#endif
#ifndef ATT_PIPE192
#define ATT_PIPE192 0
#endif
__device__ __forceinline__ void phase_attn(const Params& p, int layer, char* lds, int slot, const int wave_s) {
  const bf16_t* P = (const bf16_t*)(p.ws + WS_P); const bf16_t* QC = (const bf16_t*)(p.ws + WS_QC); const bf16_t* KVC = (const bf16_t*)(p.ws + WS_KVC);
  const bf16_t* KC = (const bf16_t*)(p.ws + WS_KC); float* OA = (float*)(p.ws + WS_OA); bf16_t* Y = (bf16_t*)(p.ws + WS_HY);
  unsigned* ctr = (unsigned*)(p.ws + WS_CTL) + slot * 16;
  volatile int* sh = (volatile int*)(lds + att::ATT_LDS);
  const int fastmask = __builtin_amdgcn_readfirstlane(((const int*)(p.ws + WS_CTL))[256 + layer]);
  const int QLEN = (layer == DEPTH - 1) ? 128 : 144;
  float* PART = (float*)(p.ws + WS_PART);
  int q = (int)(__builtin_amdgcn_s_getreg((3 << 11) | 20) & 7u), tried = 0;
  for (;;) {
    __syncthreads();
    if (TIDX == 0) { int u = -1;
      while (tried < 8) { u = (int)__hip_atomic_fetch_add(ctr + q, 1u, __ATOMIC_RELAXED, __HIP_MEMORY_SCOPE_AGENT); if (u < QLEN) break; u = -1; q = (q + 1) & 7; ++tried; }
      sh[0] = u; sh[1] = q; }
    __syncthreads();
    const int u = __builtin_amdgcn_readfirstlane(sh[0]), qx = __builtin_amdgcn_readfirstlane(sh[1]);
    if (u < 0) break;
    int type, h, qb, sp = -1; float* part = nullptr;
    if (u < 128) { const int seg = u >> 5, i = u & 31; if (seg < 2) { type = seg; h = qx >> 1; qb = 32 * (qx & 1) + i; } else { type = 2; h = qx; qb = 32 * (seg - 2) + i; } }
    else { const int m = qx * 16 + (u - 128), hd = m >> 3; sp = m & 7; qb = 64; if (hd < 4) { type = 0; h = hd; } else if (hd < 8) { type = 1; h = hd - 4; } else { type = 2; h = hd - 8; }
      part = PART + (size_t)(m * 16) * 132; }
    const int q0 = qb < 64 ? NMETA + 256 * qb : 0, nv = qb < 64 ? 256 : NMETA;
    const int kb0 = sp < 0 ? 0 : sp * 2048, nt = sp < 0 ? att::NT : (sp == 7 ? att::NT - 7 * 32 : 32);
    if (part != nullptr || !((fastmask >> type) & 1)) {
      if (type == 0) att::attn_unit<192, 1, 1, 0, 768, 768, 1024, 0, DM, INP, true>(wave_s, QC + (size_t)q0 * 768 + h * 192, KC + h * 192, KVC + h * 256 + 128, LN2, nv,
                                nullptr, Y + (size_t)q0 * DM + 1024 + h * 128, P + (size_t)q0 * INP + C_CG + h * 128, lds, kb0, nt, part);
      else if (type == 1) att::attn_unit<128, 1, 1, 0, INP, INP, INP, 0, DM, INP, true>(wave_s, P + (size_t)q0 * INP + C_BQ + h * 128, P + C_BK + (h >> 1) * 128, P + C_BV + (h >> 1) * 128, LN2, nv,
                                nullptr, Y + (size_t)q0 * DM + 512 + h * 128, P + (size_t)q0 * INP + C_BG + h * 128, lds, kb0, nt, part);
      else att::attn_unit<64, 1, 0, 0, INP, INP, INP, 1024, 0, 0, true>(wave_s, P + (size_t)q0 * INP + C_AQ + h * 64, P + C_AK + h * 64, P + C_AV + (h >> 1) * 128, LN2, nv,
                               OA + (size_t)q0 * 1024 + h * 128, nullptr, nullptr, lds, kb0, nt, part);
    } else if (type == 0) {
      att::attn_unit<192, ATT_SD192, 1, ATT_PIPE192, 768, 768, 1024, 0, DM, INP, false, true>(wave_s, QC + (size_t)q0 * 768 + h * 192, KC + h * 192, KVC + h * 256 + 128, LN2, nv,
                                nullptr, Y + (size_t)q0 * DM + 1024 + h * 128, P + (size_t)q0 * INP + C_CG + h * 128, lds);
    } else if (type == 1) {
      att::attn_unit<128, 1 + ATT_KVT2_B, 1, ATT_PIPE128, INP, INP, INP, 0, DM, INP, false, true, ATT_KVT2_B != 0>(wave_s, P + (size_t)q0 * INP + C_BQ + h * 128, P + C_BK + (h >> 1) * 128, P + C_BV + (h >> 1) * 128, LN2, nv,
                                nullptr, Y + (size_t)q0 * DM + 512 + h * 128, P + (size_t)q0 * INP + C_BG + h * 128, lds);
    } else {
      att::attn_unit<64, 1 + ATT_KVT2_A, 0, ATT_PIPE64, INP, INP, INP, 1024, 0, 0, false, true, ATT_KVT2_A != 0>(wave_s, P + (size_t)q0 * INP + C_AQ + h * 64, P + C_AK + h * 64, P + C_AV + (h >> 1) * 128, LN2, nv,
                               OA + (size_t)q0 * 1024 + h * 128, nullptr, nullptr, lds);
    }
  }
}

typedef short bf16x8_t __attribute__((ext_vector_type(8)));
template <class F>
__device__ __forceinline__ void small_gemm16(const bf16_t* __restrict__ A, const int lda, const bf16_t* __restrict__ Bt, const int N, const int K, const F& store, LAS unsigned char* lds, const int wave_s) {
  int t_ = TIDX; asm volatile("" : "+v"(t_)); const int lane = t_ & 63; const int G = gridDim.x;
  LAS f32x4* red = (LAS f32x4*)lds;
  const int kpw = K >> 3, k0 = wave_s * kpw;
  for (int blk = (int)blockIdx.x; blk < N / 16; blk += G) {
    f32x4 acc = {0.f, 0.f, 0.f, 0.f};
    const bf16_t* ap = A + (size_t)(lane & 15) * lda + (lane >> 4) * 8 + k0;
    const bf16_t* bp = Bt + (size_t)(blk * 16 + (lane & 15)) * K + (lane >> 4) * 8 + k0;
#pragma unroll 8
    for (int k = 0; k < kpw; k += 32) acc = __builtin_amdgcn_mfma_f32_16x16x32_bf16(*(const bf16x8_t*)(ap + k), *(const bf16x8_t*)(bp + k), acc, 0, 0, 0);
    red[wave_s * 64 + lane] = acc;
    __syncthreads();
    if (wave_s == 0) {
      f32x4 t = red[lane];
#pragma unroll
      for (int w = 1; w < 8; ++w) t += red[w * 64 + lane];
#pragma unroll
      for (int j = 0; j < 4; ++j) store(4 * (lane >> 4) + j, blk * 16 + (lane & 15), t[j]);
    }
    __syncthreads();
  }
}

constexpr int LDS_BYTES = 147456;
__global__ void __launch_bounds__(512, 2) hybrid_fwd(Params p) {
  extern __shared__ __attribute__((aligned(16))) unsigned char lds[];
  cg::grid_group grid = cg::this_grid();
  const int G = gridDim.x;
  const int wave_s = __builtin_amdgcn_readfirstlane((int)__builtin_amdgcn_workitem_id_x() >> 6);
  LAS unsigned char* ldsl = (LAS unsigned char*)lds;
  unsigned char* ws = p.ws;
  bf16_t* HY = (bf16_t*)(ws + WS_HY); bf16_t* P = (bf16_t*)(ws + WS_P);
  float* xmeta = (float*)(ws + WS_XMETA);

#ifndef PH_MASK
#define PH_MASK 0xFFFF
#endif
  if (TIDX < 2) ((LAS unsigned*)(ldsl + LDS_BYTES - 64))[TIDX] = 0u;
  __syncthreads();
  if (PH_MASK & 1) phase_prologue(p, ldsl, wave_s);
  grid.sync();
  const XcdBarrier bar = xcd_barrier_post((unsigned*)(ws + WS_BAR), (volatile LAS unsigned*)(ldsl + LDS_BYTES - 64), wave_s);
#define GSYNC() xcd_barrier(bar, wave_s)
#pragma unroll 1
  for (int layer = 0; layer < DEPTH; ++layer) {
    const float lambda_init = (layer == 0) ? 0.2f : (0.8f - 0.6f * 0.7408182206817179f);
    const float* res_meta = (layer == 0) ? p.meta : xmeta; const float* res_body = (layer == 0) ? p.x : p.out;
    if (PH_MASK & 2) phase_rmsnorm(res_meta, res_body, p.norm_w + layer * DM, HY, wave_s);
    GSYNC();
    if (PH_MASK & 4) { pg8::Gemm g{HY, (const bf16_t*)(ws + WS_WIN) + (size_t)layer * INP * DM, MP, INP, DM, DM}; pg8::StaticOrder S; S.init(MP, INP, G, (int)blockIdx.x);
      pg8::EpiBf16 E{P, INP};
      pg8::gemm_phase<pg8::EpiBf16, pg8::StaticOrder, true, true>(ldsl, g, S, E, wave_s); }
    GSYNC();
    if (PH_MASK & 8) phase_post1(p, layer, wave_s);
    GSYNC();
    if (PH_MASK & 16) { pg8::Gemm g{P + C_CQ, (const bf16_t*)(ws + WS_WUQ) + (size_t)layer * 768 * 384, MP, 768, 384, INP}; pg8::StaticOrder S; S.init(MP, 768, G, (int)blockIdx.x);
      pg8::EpiBf16 E{(bf16_t*)(ws + WS_QC), 768};
      pg8::gemm_phase<pg8::EpiBf16, pg8::StaticOrder, true, true>(ldsl, g, S, E, wave_s); }
    if (PH_MASK & 16) { pg8::Gemm g{P + C_CKV, (const bf16_t*)(ws + WS_WUKV) + (size_t)layer * 1024 * 256, SEQ, 1024, 256, INP}; pg8::StaticOrder S; S.init(SEQ, 1024, G, (int)((blockIdx.x + 195) % G));
      pg8::EpiBf16 E{(bf16_t*)(ws + WS_KVC), 1024};
      pg8::gemm_phase<pg8::EpiBf16, pg8::StaticOrder, true, true>(ldsl, g, S, E, wave_s);
      bf16_t* kvc = (bf16_t*)(ws + WS_KVC);
      small_gemm16(P + (size_t)SEQ * INP + C_CKV, INP, g.Bt, 1024, 256, [=](int r, int c, float v) { kvc[(size_t)(SEQ + r) * 1024 + c] = (bf16_t)f2bf(v); }, ldsl, wave_s); }
    if (PH_MASK & 16) { pg8::Gemm g{(const bf16_t*)(ws + WS_POOL), (const bf16_t*)(ws + WS_WD) + (size_t)layer * 512 * 512, MP, 512, 512, 512}; pg8::StaticOrder S; S.init(MP, 512, G, (int)((blockIdx.x + 199) % G));
      pg8::EpiBf16 E{P + C_DU, INP};
      pg8::gemm_phase<pg8::EpiBf16, pg8::StaticOrder, true, true>(ldsl, g, S, E, wave_s); }
    GSYNC();
    if (PH_MASK & 32) phase_post2(p, layer, wave_s);
    GSYNC();
    if (PH_MASK & 64) phase_attn(p, layer, (char*)lds, layer, wave_s);
#ifdef PROBE_DUP_ATT
    GSYNC(); if (layer == 0) phase_attn(p, layer, (char*)lds, 4, wave_s);
#endif
    GSYNC();
    if (PH_MASK & 128) phase_post3(p, layer, lambda_init, wave_s);
    GSYNC();
    if (PH_MASK & 256) { pg8::Gemm g{HY, (const bf16_t*)(ws + WS_WOUT) + (size_t)layer * DM * DM, SEQ, DM, DM, DM}; pg8::StaticOrder S; S.init(SEQ, DM, G, (int)blockIdx.x);
      pg8::EpiRes E{res_meta, res_body, (layer == 0) ? xmeta : nullptr, p.out, DM, NMETA, LROWS};
      pg8::gemm_phase<pg8::EpiRes, pg8::StaticOrder, true, true>(ldsl, g, S, E, wave_s);
      { const float* rb = res_body; float* ob = p.out;
        small_gemm16(HY + (size_t)SEQ * DM, DM, g.Bt, DM, DM, [=](int r, int c, float v) { const size_t i = (size_t)(SEQ - NMETA + r) * DM + c; ob[i] = rb[i] + v; }, ldsl, wave_s); } }
    if (layer + 1 < DEPTH) GSYNC();
  }
}

extern "C" void kernel_launch(void* const* d_in, const int* in_sizes, int n_in, void* d_out, int out_size, void* d_ws, size_t ws_size, hipStream_t stream) {
  static int grid = 0;
  if (grid == 0) {
    if (n_in != 19 || in_sizes[0] != SEQ * DM || out_size != SEQ * DM || ws_size < WS_END) {
      fprintf(stderr, "kernel_launch: unexpected shapes: n_in %d in0 %d out %d ws %zu (need %zu)\n", n_in, n_in > 0 ? in_sizes[0] : -1, out_size, ws_size, (size_t)WS_END); grid = -1; return; }
    int dev = 0, cus = 0, per_cu = 0;
    hipGetDevice(&dev); hipDeviceGetAttribute(&cus, hipDeviceAttributeMultiprocessorCount, dev);
    if (hipFuncSetAttribute((const void*)hybrid_fwd, hipFuncAttributeMaxDynamicSharedMemorySize, LDS_BYTES) != hipSuccess) { fprintf(stderr, "kernel_launch: hipFuncSetAttribute failed\n"); grid = -1; return; }
    if (hipOccupancyMaxActiveBlocksPerMultiprocessor(&per_cu, (const void*)hybrid_fwd, 512, LDS_BYTES) != hipSuccess || per_cu < 1) { fprintf(stderr, "kernel_launch: occupancy query says %d\n", per_cu); per_cu = 1; }
    (void)hipGetLastError();
    grid = cus * 1;
  }
  if (grid < 0) return;
  Params p{};
  const float** fp = (const float**)&p;
  for (int i = 0; i < 19; ++i) fp[i] = (const float*)d_in[i];
  p.out = (float*)d_out; p.ws = (unsigned char*)d_ws;
  for (int j = 0; j < 8; ++j) p.inv_a[j] = (float)pow(500000.0, -(double)(2 * j) / 16.0);
  for (int j = 0; j < 32; ++j) { p.inv_b[j] = (float)pow(10000.0, -(double)(2 * j) / 64.0); p.inv_c[j] = (float)pow(500000.0, -(double)(2 * j) / 64.0); }
  void* args[] = {&p};
  hipError_t e = hipLaunchCooperativeKernel((const void*)hybrid_fwd, dim3(grid), dim3(512), args, LDS_BYTES, stream);
  if (e != hipSuccess) fprintf(stderr, "kernel_launch: cooperative launch failed: %s (grid %d)\n", hipGetErrorString(e), grid);
}
```

```cpp
#include <hip/hip_runtime.h>
#include <hip/hip_cooperative_groups.h>
#include <hip/hip_bf16.h>
#include <cstdio>
#include <cstdint>
#include <cmath>
namespace cg = cooperative_groups;
__device__ __forceinline__ int lane_id_v() { int l; asm volatile("v_mbcnt_lo_u32_b32 %0, -1, 0\n\tv_mbcnt_hi_u32_b32 %0, -1, %0" : "=v"(l)); return l; }
#define TIDX ((int)((wave_s << 6) | lane_id_v()))

namespace pg8 {
#define PG8_LAS __attribute__((address_space(3)))
typedef unsigned short bf16_t;
typedef short bf16x8 __attribute__((ext_vector_type(8)));
typedef float f32x4 __attribute__((ext_vector_type(4)));
typedef unsigned u32x4 __attribute__((ext_vector_type(4)));
constexpr int BM = 256, BK = 64, HALF = 128, HTB = HALF * BK * 2  , STAGE_BYTES = 8 * HTB, NXCD = 8, WGM = 8;

__host__ __device__ __forceinline__ int lds_byte(int r, int c) { const int st = (r >> 4) * 2 + (c >> 5), rr = r & 15, cc = c & 31, ob = rr * 64 + cc * 2; return st * 1024 + (ob ^ (((ob >> 9) & 1) << 5)); }
__host__ __device__ __forceinline__ void stage_rc(int b, int& R, int& C) { const int st = b / 1024, sb = b % 1024, swz = sb ^ (((sb >> 9) & 1) << 5); R = (st >> 1) * 16 + swz / 64; C = (st & 1) * 32 + (swz % 64) / 2; }
__host__ __device__ __forceinline__ int perm32(int rho) { const int n = rho >> 4, i = rho & 15; return 8 * (i >> 2) + 4 * n + (i & 3); }

struct Unit { int pm, pn; };
struct Gemm { const bf16_t* A; const bf16_t* Bt; int M, N, K, lda; };

struct StaticOrder {
    int nM, nN, nwg, G, c;
    __host__ __device__ void init(int M, int N, int G_, int c_) { nM = M / BM; nN = N / BM; nwg = nM * nN; G = G_; c = c_; }
    __host__ __device__ bool next(int i, Unit& u) const {
        const long L = (long)i * G + c; if (L >= nwg) return false;
        int wgid = (int)L; { const int q = nwg / NXCD, r = nwg % NXCD, xcd = wgid % NXCD, off = wgid / NXCD; wgid = (xcd < r ? xcd * (q + 1) : r * (q + 1) + (xcd - r) * q) + off; }
        const int nig = WGM * nN, gid = wgid / nig, fm = gid * WGM, gsz = (nM - fm) < WGM ? (nM - fm) : WGM;
        u.pm = fm + ((wgid % nig) % gsz); u.pn = (wgid % nig) / gsz; return true;
    }
    __device__ __forceinline__ void a_ready(const Unit&) const {}
    __device__ __forceinline__ void done(const Unit&) const {}
};

__device__ __forceinline__ unsigned cvt_pk_bf16(float lo, float hi) { unsigned r; asm volatile("v_cvt_pk_bf16_f32 %0, %1, %2" : "=v"(r) : "v"(lo), "v"(hi)); return r; }

struct EpiBf16 {
    static constexpr bool PERM = true, AFTER_DRAIN = false;
    bf16_t* O; int ldc;
    __device__ __forceinline__ void operator()(const f32x4 (&acc)[2][2][4][2], const Unit& u, int wr, int wc, int fr, int fq) const {
        const int row0 = u.pm * BM + wr * 64 + fr; const int col0 = u.pn * BM + wc * 32 + 8 * fq;
#pragma unroll
        for (int ai = 0; ai < 2; ++ai)
#pragma unroll
            for (int m = 0; m < 4; ++m) { bf16_t* rowp = O + (size_t)(row0 + ai * HALF + m * 16) * ldc + col0;
#pragma unroll
                for (int bj = 0; bj < 2; ++bj) { const f32x4 v0 = acc[ai][bj][m][0], v1 = acc[ai][bj][m][1];
                    u32x4 w; w.x = cvt_pk_bf16(v0[0], v0[1]); w.y = cvt_pk_bf16(v0[2], v0[3]); w.z = cvt_pk_bf16(v1[0], v1[1]); w.w = cvt_pk_bf16(v1[2], v1[3]);
                    *(u32x4*)(rowp + bj * HALF) = w; } }
    }
};
struct EpiRes {
    static constexpr bool PERM = false, AFTER_DRAIN = false;
    const float* res_meta; const float* res_body; float* out_meta; float* out_body; int ldc, nmeta, lrows; int stream_out;
    __device__ __forceinline__ void operator()(const f32x4 (&acc)[2][2][4][2], const Unit& u, int wr, int wc, int fr, int fq) const {
        const int row0 = u.pm * BM + wr * 64 + fr; const int col0 = u.pn * BM + wc * 32 + 4 * fq;
#pragma unroll
        for (int ai = 0; ai < 2; ++ai)
#pragma unroll
            for (int m = 0; m < 4; ++m) { const int r = row0 + ai * HALF + m * 16;
                if (r < lrows) {
                    const float* rp = (r < nmeta) ? res_meta + (size_t)r * ldc : res_body + (size_t)(r - nmeta) * ldc;
                    float* op = (r < nmeta) ? out_meta : out_body;
                    if (op) { op += (r < nmeta) ? (size_t)r * ldc : (size_t)(r - nmeta) * ldc;
#pragma unroll
                    for (int bj = 0; bj < 2; ++bj)
#pragma unroll
                        for (int n = 0; n < 2; ++n) { const int c = col0 + bj * HALF + n * 16; const f32x4 b = *(const f32x4*)(rp + c); const f32x4 v_ = b + acc[ai][bj][m][n];
                          if (stream_out) __builtin_nontemporal_store(v_, (f32x4*)(op + c)); else *(f32x4*)(op + c) = v_; } } } }
    }
};

template <class Epi, class Sched, bool ALIGN_EPI = false, bool SP2 = false>
__device__ __forceinline__ void gemm_phase(PG8_LAS unsigned char* lds, const Gemm g, const Sched& S, const Epi& E, const int wave_s) {
    int tid_ = TIDX; asm volatile("" : "+v"(tid_));
    const int tid = tid_, wid = __builtin_amdgcn_readfirstlane(tid >> 6), lane = tid & 63, wr = wid >> 2, wc = wid & 3, fr = lane & 15, fq = lane >> 4;
    const int K = g.K, nt = K / BK;
    unsigned voffA[2], voffB[2];
#pragma unroll
    for (int i = 0; i < 2; ++i) { int R, C; stage_rc(tid * 16 + i * 8192, R, C); const int Rb = Epi::PERM ? ((R & ~31) + perm32(R & 31)) : R;
        voffA[i] = (unsigned)(R * g.lda + C) * 2u; voffB[i] = (unsigned)(Rb * K + C) * 2u; }
    const size_t kstep = (size_t)(BK * 2);
    const size_t hstep = (size_t)HALF * K * 2;
    const size_t tstep = 2 * hstep; const size_t hstepA = (size_t)HALF * g.lda * 2, tstepA = 2 * hstepA;
    const unsigned ldsw = (unsigned)wid * 1024u;
    const int aoff = lds_byte(wr * 64 + fr, fq * 8), boff = lds_byte(wc * 32 + fr, fq * 8);
#define PG8_SA(b, h) (((b) * 2 + (h)) * HTB)
#define PG8_SB(b, h) ((4 + (b) * 2 + (h)) * HTB)
#define PG8_STAGE(bufoff, gbase, voff) do { _Pragma("unroll") for (int _i = 0; _i < 2; ++_i) \
        __builtin_amdgcn_global_load_lds((const unsigned*)((const char*)(gbase) + (voff)[_i]), (PG8_LAS unsigned*)(lds + (bufoff) + ldsw + _i * 8192), 16, 0, 0); } while (0)
#define PG8_LDA(dst, b, h) do { _Pragma("unroll") for (int m = 0; m < 4; ++m) _Pragma("unroll") for (int k = 0; k < 2; ++k) dst[m][k] = *(const PG8_LAS bf16x8*)(lds + PG8_SA(b, h) + aoff + m * 2048 + k * 1024); } while (0)
#define PG8_LDB(dst, b, h) do { _Pragma("unroll") for (int n = 0; n < 2; ++n) _Pragma("unroll") for (int k = 0; k < 2; ++k) dst[n][k] = *(const PG8_LAS bf16x8*)(lds + PG8_SB(b, h) + boff + n * 2048 + k * 1024); } while (0)
#define PG8_MMA(ai, bj, At, Bt) do { __builtin_amdgcn_s_setprio(1); _Pragma("unroll") for (int m = 0; m < 4; ++m) _Pragma("unroll") for (int n = 0; n < 2; ++n) _Pragma("unroll") for (int k = 0; k < 2; ++k) \
        acc[ai][bj][m][n] = __builtin_amdgcn_mfma_f32_16x16x32_bf16(Bt[n][k], At[m][k], acc[ai][bj][m][n], 0, 0, 0); __builtin_amdgcn_s_setprio(0); } while (0)
#define PG8_WAIT_V(n) asm volatile("s_waitcnt vmcnt(" #n ")" ::: "memory")
#define PG8_WAIT_L(n) asm volatile("s_waitcnt lgkmcnt(" #n ")" ::: "memory")
#define PG8_BAR __builtin_amdgcn_s_barrier()
#define PG8_SCHED __builtin_amdgcn_sched_barrier(0)
    Unit cur, nxt; int ui = 0;
    if (!S.next(0, cur)) return;
    f32x4 acc[2][2][4][2];
#pragma unroll
    for (int a = 0; a < 2; ++a)
#pragma unroll
        for (int b = 0; b < 2; ++b)
#pragma unroll
            for (int m = 0; m < 4; ++m)
#pragma unroll
                for (int n = 0; n < 2; ++n) acc[a][b][m][n] = (f32x4){0.f, 0.f, 0.f, 0.f};
    bf16x8 At[4][2], B0[2][2], B1[2][2];
    const char* cA = (const char*)g.A + (size_t)cur.pm * tstepA; const char* cB = (const char*)g.Bt + (size_t)cur.pn * tstep;
    S.a_ready(cur);
    if constexpr (SP2) {
        PG8_STAGE(PG8_SB(0, 0), cB, voffB); PG8_STAGE(PG8_SB(0, 1), cB + hstep, voffB); PG8_STAGE(PG8_SA(0, 0), cA, voffA); PG8_STAGE(PG8_SA(0, 1), cA + hstepA, voffA);
        if (wr == 1) PG8_BAR;
        PG8_WAIT_V(2); PG8_BAR;
        PG8_STAGE(PG8_SB(1, 0), cB + kstep, voffB); PG8_STAGE(PG8_SA(1, 0), cA + kstep, voffA); PG8_STAGE(PG8_SB(1, 1), cB + hstep + kstep, voffB);
        PG8_WAIT_V(6); PG8_BAR;
    } else {
        PG8_STAGE(PG8_SB(0, 0), cB, voffB); PG8_STAGE(PG8_SA(0, 0), cA, voffA); PG8_STAGE(PG8_SB(0, 1), cB + hstep, voffB); PG8_STAGE(PG8_SA(0, 1), cA + hstepA, voffA);
        if (wr == 1) PG8_BAR;
        PG8_WAIT_V(4); PG8_BAR;
        PG8_STAGE(PG8_SB(1, 0), cB + kstep, voffB); PG8_STAGE(PG8_SA(1, 0), cA + kstep, voffA); PG8_STAGE(PG8_SB(1, 1), cB + hstep + kstep, voffB);
        PG8_WAIT_V(6); PG8_BAR;
    }
    for (;;) {
        const bool has_next = S.next(ui + 1, nxt);
        const char* nA = has_next ? (const char*)g.A + (size_t)nxt.pm * tstepA : cA; const char* nB = has_next ? (const char*)g.Bt + (size_t)nxt.pn * tstep : cB;
        for (int t = 0; t < nt; t += 2) {
            const bool last = (t == nt - 2);
            const char* a1 = cA + (size_t)(t + 1) * kstep;
            const char* a2 = last ? nA : cA + (size_t)(t + 2) * kstep; const char* b2 = last ? nB : cB + (size_t)(t + 2) * kstep;
            const char* a3 = a2 + kstep; const char* b3 = b2 + kstep;
            if (last && has_next) S.a_ready(nxt);
            if constexpr (SP2) {
            PG8_LDB(B0, 0, 0); PG8_LDB(B1, 0, 1); PG8_SCHED; PG8_LDA(At, 0, 0); PG8_STAGE(PG8_SA(1, 1), a1 + hstepA, voffA);
            PG8_WAIT_V(8); PG8_WAIT_L(0); PG8_BAR; PG8_MMA(0, 0, At, B0); PG8_MMA(0, 1, At, B1); PG8_BAR; PG8_SCHED;
            PG8_LDA(At, 0, 1); PG8_STAGE(PG8_SB(0, 0), b2, voffB); PG8_STAGE(PG8_SB(0, 1), b2 + hstep, voffB); PG8_STAGE(PG8_SA(0, 0), a2, voffA);
            PG8_WAIT_V(8); PG8_WAIT_L(0); PG8_BAR; PG8_MMA(1, 0, At, B0); PG8_MMA(1, 1, At, B1); PG8_BAR; PG8_SCHED;
            PG8_LDB(B0, 1, 0); PG8_LDB(B1, 1, 1); PG8_SCHED; PG8_LDA(At, 1, 0); PG8_STAGE(PG8_SA(0, 1), a2 + hstepA, voffA);
            PG8_WAIT_V(8); PG8_WAIT_L(0); PG8_BAR; PG8_MMA(0, 0, At, B0); PG8_MMA(0, 1, At, B1); PG8_BAR; PG8_SCHED;
            PG8_LDA(At, 1, 1); PG8_STAGE(PG8_SB(1, 0), b3, voffB); PG8_STAGE(PG8_SB(1, 1), b3 + hstep, voffB); PG8_STAGE(PG8_SA(1, 0), a3, voffA);
            PG8_WAIT_V(8); PG8_WAIT_L(0); PG8_BAR; PG8_MMA(1, 0, At, B0); PG8_MMA(1, 1, At, B1); PG8_BAR; PG8_SCHED;
            } else {
            PG8_LDB(B0, 0, 0); PG8_SCHED; PG8_LDA(At, 0, 0); PG8_STAGE(PG8_SA(1, 1), a1 + hstepA, voffA);
            PG8_WAIT_L(8); PG8_BAR; PG8_WAIT_L(0); PG8_MMA(0, 0, At, B0); PG8_BAR; PG8_SCHED;
            PG8_LDB(B1, 0, 1); PG8_STAGE(PG8_SB(0, 0), b2, voffB);
            PG8_BAR; PG8_WAIT_L(0); PG8_MMA(0, 1, At, B1); PG8_BAR;
            PG8_LDA(At, 0, 1); PG8_STAGE(PG8_SA(0, 0), a2, voffA);
            PG8_BAR; PG8_WAIT_L(0); PG8_MMA(1, 0, At, B0); PG8_BAR; PG8_SCHED;
            PG8_STAGE(PG8_SB(0, 1), b2 + hstep, voffB);
            PG8_WAIT_V(6); PG8_BAR; PG8_MMA(1, 1, At, B1); PG8_BAR;
            PG8_LDB(B0, 1, 0); PG8_SCHED; PG8_LDA(At, 1, 0); PG8_STAGE(PG8_SA(0, 1), a2 + hstepA, voffA);
            PG8_WAIT_L(8); PG8_BAR; PG8_WAIT_L(0); PG8_MMA(0, 0, At, B0); PG8_BAR; PG8_SCHED;
            PG8_LDB(B1, 1, 1); PG8_STAGE(PG8_SB(1, 0), b3, voffB);
            PG8_BAR; PG8_WAIT_L(0); PG8_MMA(0, 1, At, B1); PG8_BAR;
            PG8_LDA(At, 1, 1); PG8_STAGE(PG8_SA(1, 0), a3, voffA);
            PG8_BAR; PG8_WAIT_L(0); PG8_MMA(1, 0, At, B0); PG8_BAR; PG8_SCHED;
            PG8_STAGE(PG8_SB(1, 1), b3 + hstep, voffB);
            PG8_WAIT_V(6); PG8_BAR; PG8_MMA(1, 1, At, B1); PG8_BAR;
            }
        }
        if constexpr (ALIGN_EPI) { if (wr == 0) PG8_BAR; }
        if constexpr (!Epi::AFTER_DRAIN) { E(acc, cur, wr, wc, fr, fq); S.done(cur); }
        if (!has_next) break;
#pragma unroll
        for (int a = 0; a < 2; ++a)
#pragma unroll
            for (int b = 0; b < 2; ++b)
#pragma unroll
                for (int m = 0; m < 4; ++m)
#pragma unroll
                    for (int n = 0; n < 2; ++n) acc[a][b][m][n] = (f32x4){0.f, 0.f, 0.f, 0.f};
        cur = nxt; cA = nA; cB = nB; ++ui;
        if constexpr (ALIGN_EPI) { if (wr == 1) PG8_BAR; }
    }
    PG8_WAIT_V(0);
    if constexpr (!ALIGN_EPI) { if (wr == 0) PG8_BAR; }
    PG8_BAR;
    if constexpr (Epi::AFTER_DRAIN) { E.fused(acc, cur, wr, wc, fr, fq, lds, wid, lane); S.done(cur); }
#undef PG8_SA
#undef PG8_SB
#undef PG8_STAGE
#undef PG8_LDA
#undef PG8_LDB
#undef PG8_MMA
#undef PG8_WAIT_V
#undef PG8_WAIT_L
#undef PG8_BAR
#undef PG8_SCHED
}
}

#ifndef ATT_KPRELOAD
#define ATT_KPRELOAD 1
#endif
#ifndef ATT_KEARLY
#define ATT_KEARLY 1
#endif
#ifndef ATT_STEP_VPIPE
#define ATT_STEP_VPIPE 1
#endif
#ifndef ATT_STEP
#define ATT_STEP 0
#endif
namespace att {
using bf16 = unsigned short;
using bf16x8 = __attribute__((ext_vector_type(8))) short;
using s16x4  = __attribute__((ext_vector_type(4))) short;
using f32x16 = __attribute__((ext_vector_type(16))) float;
using u32x4  = __attribute__((ext_vector_type(4))) unsigned;
constexpr int NW = 8, QBLK = 32, KVBLK = 64;
constexpr int LROWS = 16400;
constexpr int NT = 257;
constexpr float THR = 8.f;
constexpr int SHM_V = KVBLK * 128 * 2;
constexpr int K_OFF = 4 * SHM_V, WS_OFF = K_OFF + 4 * KVBLK * 128 * 2, ATT_LDS = WS_OFF + NW * 64 * 4;
static_assert(2 * KVBLK * 192 * 2 <= 4 * KVBLK * 128 * 2, "K region");
#define SBAR() __builtin_amdgcn_sched_barrier(0)
__device__ __forceinline__ int crow(int r, int hi) { return (r & 3) + 8 * (r >> 2) + 4 * hi; }
__device__ __forceinline__ unsigned cvtpk(float lo, float hi) { unsigned r; asm volatile("v_cvt_pk_bf16_f32 %0, %1, %2" : "=v"(r) : "v"(lo), "v"(hi)); return r; }
__device__ __forceinline__ bf16x8 ld8(const bf16* p) { return *reinterpret_cast<const bf16x8*>(p); }

template <bool FIXM>
__device__ __forceinline__ void partialSM(f32x16& p0, f32x16& p1, float& m_reg, float& mn, float& alpha, const float C, const float thrS, const int kb, const int hi) {
  if constexpr (FIXM) {
#pragma unroll
    for (int r = 0; r < 16; ++r) p0[r] = __builtin_amdgcn_exp2f(p0[r]);
    if (kb + KVBLK > LROWS) {
#pragma unroll
      for (int r = 0; r < 16; ++r) { if (kb + crow(r, hi) >= LROWS) p0[r] = 0.f; }
    }
    return;
  }
  if (kb + KVBLK > LROWS) {
#pragma unroll
    for (int r = 0; r < 16; ++r) { const int k0 = kb + crow(r, hi); if (k0 >= LROWS) p0[r] = -1e30f; if (k0 + 32 >= LROWS) p1[r] = -1e30f; }
  }
  float pmax = p0[0];
#pragma unroll
  for (int r = 1; r < 16; ++r) pmax = fmaxf(pmax, p0[r]);
#pragma unroll
  for (int r = 0; r < 16; ++r) pmax = fmaxf(pmax, p1[r]);
  { auto rr = __builtin_amdgcn_permlane32_swap(__float_as_uint(pmax), __float_as_uint(pmax), false, false);
    pmax = fmaxf(__uint_as_float(rr[0]), __uint_as_float(rr[1])); }
  if (__builtin_expect(__all(pmax - m_reg <= thrS), 1)) { mn = m_reg; alpha = 1.f; }
  else { mn = fmaxf(m_reg, pmax); alpha = __builtin_amdgcn_exp2f((m_reg - mn) * C); m_reg = mn; }
  const float mnC = -mn * C;
#pragma unroll
  for (int r = 0; r < 16; ++r) p0[r] = fmaf(p0[r], C, mnC);
#pragma unroll
  for (int r = 0; r < 16; ++r) p1[r] = fmaf(p1[r], C, mnC);
#pragma unroll
  for (int r = 0; r < 16; ++r) p0[r] = __builtin_amdgcn_exp2f(p0[r]);
}
template <bool FIXM>
__device__ __forceinline__ void finishSM(f32x16& p0, f32x16& p1, float alpha, float& l_reg, bf16x8& pa0, bf16x8& pa1, bf16x8& pa2, bf16x8& pa3, const int kb, const int hi) {
#pragma unroll
  for (int r = 0; r < 16; ++r) p1[r] = __builtin_amdgcn_exp2f(p1[r]);
  if constexpr (FIXM) { if (kb + KVBLK > LROWS) {
#pragma unroll
    for (int r = 0; r < 16; ++r) { if (kb + 32 + crow(r, hi) >= LROWS) p1[r] = 0.f; } } }
  float ps = 0;
#pragma unroll
  for (int r = 0; r < 16; ++r) ps += p0[r];
#pragma unroll
  for (int r = 0; r < 16; ++r) ps += p1[r];
  if constexpr (FIXM) l_reg += ps; else l_reg = l_reg * alpha + ps;
#define PK4(P, BASE, OUT) do { unsigned a0 = cvtpk(P[BASE + 0], P[BASE + 1]), a1 = cvtpk(P[BASE + 2], P[BASE + 3]);   \
    unsigned b0 = cvtpk(P[BASE + 4], P[BASE + 5]), b1 = cvtpk(P[BASE + 6], P[BASE + 7]);                              \
    u32x4 w = {a0, a1, b0, b1}; OUT = *reinterpret_cast<bf16x8*>(&w); } while (0)
  PK4(p0, 0, pa0); PK4(p0, 8, pa1); PK4(p1, 0, pa2); PK4(p1, 8, pa3);
#undef PK4
}
#define KSWZ(KP, row, colB) ((row) * (KP) + ((colB) ^ ((KP) == 256 ? (((row) & 15) << 4) : ((((row) >> 1) & 7) << 4))))
template <int DQK>
__device__ __forceinline__ void qkt(f32x16& p0, f32x16& p1, const char* Ks, const bf16x8* qr, int r32, int hi) {
  constexpr int KP = DQK * 2;
  p0 = f32x16{}; p1 = f32x16{};
  if constexpr (DQK == 64 && ATT_KPRELOAD) {
    bf16x8 ka[4], kq[4];
#pragma unroll
    for (int d0 = 0; d0 < 4; ++d0) { const int cb = (d0 * 16 + hi * 8) * 2;
      ka[d0] = *reinterpret_cast<const bf16x8*>(Ks + KSWZ(KP, r32, cb)); kq[d0] = *reinterpret_cast<const bf16x8*>(Ks + KSWZ(KP, 32 + r32, cb)); }
    SBAR();
#pragma unroll
    for (int d0 = 0; d0 < 4; ++d0) { p0 = __builtin_amdgcn_mfma_f32_32x32x16_bf16(ka[d0], qr[d0], p0, 0, 0, 0); p1 = __builtin_amdgcn_mfma_f32_32x32x16_bf16(kq[d0], qr[d0], p1, 0, 0, 0); }
    return;
  }
#pragma unroll
  for (int d0 = 0; d0 < DQK / 16; ++d0) { const int cb = (d0 * 16 + hi * 8) * 2;
    bf16x8 b0 = *reinterpret_cast<const bf16x8*>(Ks + KSWZ(KP, r32, cb));
    bf16x8 b1 = *reinterpret_cast<const bf16x8*>(Ks + KSWZ(KP, 32 + r32, cb));
    p0 = __builtin_amdgcn_mfma_f32_32x32x16_bf16(b0, qr[d0], p0, 0, 0, 0);
    p1 = __builtin_amdgcn_mfma_f32_32x32x16_bf16(b1, qr[d0], p1, 0, 0, 0); }
}
__device__ __forceinline__ int v_st(int k, int c) { const int kk = k; return ((kk >> 3) * 4 + (c >> 5)) * 512 + ((kk & 7) * 32 + (c & 31)) * 2; }
__device__ __forceinline__ int v_rd_base(int lane) { return ((lane & 3) << 3) | (((lane >> 2) & 3) << 6) | (((lane >> 4) & 1) << 5) | (((lane >> 5) & 1) << 8); }
constexpr int v_rd_off(int d0, int ks, int half) { return d0 * 512 + ks * 4096 + half * 2048; }
template <int OFF> __device__ __forceinline__ s16x4 tr_read(int vb) {
  s16x4 r; asm volatile("ds_read_b64_tr_b16 %0, %1 offset:%2" : "=&v"(r) : "v"(vb), "i"(OFF) : "memory"); return r;
}
template <int D0> __device__ __forceinline__ void pv_one(f32x16& od, int vb, bf16x8 pa0, bf16x8 pa1, bf16x8 pa2, bf16x8 pa3) {
  const s16x4 l0 = tr_read<v_rd_off(D0, 0, 0)>(vb), h0 = tr_read<v_rd_off(D0, 0, 1)>(vb), l1 = tr_read<v_rd_off(D0, 1, 0)>(vb), h1 = tr_read<v_rd_off(D0, 1, 1)>(vb);
  const s16x4 l2 = tr_read<v_rd_off(D0, 2, 0)>(vb), h2 = tr_read<v_rd_off(D0, 2, 1)>(vb), l3 = tr_read<v_rd_off(D0, 3, 0)>(vb), h3 = tr_read<v_rd_off(D0, 3, 1)>(vb);
  asm volatile("s_waitcnt lgkmcnt(0)" ::: "memory"); SBAR();
#define PK(L, H) (bf16x8){L[0], L[1], L[2], L[3], H[0], H[1], H[2], H[3]}
  od = __builtin_amdgcn_mfma_f32_32x32x16_bf16(pa0, PK(l0, h0), od, 0, 0, 0);
  od = __builtin_amdgcn_mfma_f32_32x32x16_bf16(pa1, PK(l1, h1), od, 0, 0, 0);
  od = __builtin_amdgcn_mfma_f32_32x32x16_bf16(pa2, PK(l2, h2), od, 0, 0, 0);
  od = __builtin_amdgcn_mfma_f32_32x32x16_bf16(pa3, PK(l3, h3), od, 0, 0, 0);
#undef PK
}
__device__ __forceinline__ void pv_d0(f32x16* o, int vb, bf16x8 pa0, bf16x8 pa1, bf16x8 pa2, bf16x8 pa3) {
  pv_one<0>(o[0], vb, pa0, pa1, pa2, pa3); pv_one<1>(o[1], vb, pa0, pa1, pa2, pa3); pv_one<2>(o[2], vb, pa0, pa1, pa2, pa3); pv_one<3>(o[3], vb, pa0, pa1, pa2, pa3);
}
__device__ __forceinline__ float bf2f(unsigned short b) { return __uint_as_float((unsigned)b << 16); }
__device__ __forceinline__ unsigned f2bf(float f) { unsigned u = __float_as_uint(f); return (u + 0x7fffu + ((u >> 16) & 1u)) >> 16; }
struct VF { s16x4 l0, h0, l1, h1, l2, h2, l3, h3; };
template <int D0> __device__ __forceinline__ void v_issue(VF& f, int vb) {
  f.l0 = tr_read<v_rd_off(D0, 0, 0)>(vb); f.h0 = tr_read<v_rd_off(D0, 0, 1)>(vb); f.l1 = tr_read<v_rd_off(D0, 1, 0)>(vb); f.h1 = tr_read<v_rd_off(D0, 1, 1)>(vb);
  f.l2 = tr_read<v_rd_off(D0, 2, 0)>(vb); f.h2 = tr_read<v_rd_off(D0, 2, 1)>(vb); f.l3 = tr_read<v_rd_off(D0, 3, 0)>(vb); f.h3 = tr_read<v_rd_off(D0, 3, 1)>(vb);
}
__device__ __forceinline__ void pv_mma(f32x16& od, const VF& f, bf16x8 pa0, bf16x8 pa1, bf16x8 pa2, bf16x8 pa3) {
#define PK(L, H) (bf16x8){L[0], L[1], L[2], L[3], H[0], H[1], H[2], H[3]}
  od = __builtin_amdgcn_mfma_f32_32x32x16_bf16(pa0, PK(f.l0, f.h0), od, 0, 0, 0);
  od = __builtin_amdgcn_mfma_f32_32x32x16_bf16(pa1, PK(f.l1, f.h1), od, 0, 0, 0);
  od = __builtin_amdgcn_mfma_f32_32x32x16_bf16(pa2, PK(f.l2, f.h2), od, 0, 0, 0);
  od = __builtin_amdgcn_mfma_f32_32x32x16_bf16(pa3, PK(f.l3, f.h3), od, 0, 0, 0);
#undef PK
}
__device__ __forceinline__ void pv_pipe(f32x16* o, int vb, VF& f0, VF& f1, bf16x8 pa0, bf16x8 pa1, bf16x8 pa2, bf16x8 pa3) {
  v_issue<1>(f1, vb); asm volatile("s_waitcnt lgkmcnt(8)" ::: "memory"); SBAR(); pv_mma(o[0], f0, pa0, pa1, pa2, pa3); SBAR();
  v_issue<2>(f0, vb); asm volatile("s_waitcnt lgkmcnt(8)" ::: "memory"); SBAR(); pv_mma(o[1], f1, pa0, pa1, pa2, pa3); SBAR();
  v_issue<3>(f1, vb); asm volatile("s_waitcnt lgkmcnt(8)" ::: "memory"); SBAR(); pv_mma(o[2], f0, pa0, pa1, pa2, pa3); SBAR();
  asm volatile("s_waitcnt lgkmcnt(0)" ::: "memory"); SBAR(); pv_mma(o[3], f1, pa0, pa1, pa2, pa3);
}

template <int DQK, int SDEPTH, int MODE, int PIPE, int ldq, int ldk, int ldv, int ldo, int ldy, int ldg, bool SPLIT = false, bool FIXM = false, bool KVT2 = false>
__device__ __forceinline__ void attn_unit(const int wave_s, const bf16* __restrict__ Qb, const bf16* __restrict__ Kh, const bf16* __restrict__ Vh,
                                          const float scale, const int nvalid, float* __restrict__ Of, bf16* __restrict__ Yb,
                                          const bf16* __restrict__ Gb, char* lds, const int kb0_ = 0, const int nt_ = NT, float* __restrict__ part = nullptr) {
  const int kb0 = SPLIT ? kb0_ : 0, nt = SPLIT ? nt_ : NT;
  Kh += (long)kb0 * ldk; Vh += (long)kb0 * ldv;
  constexpr int ND0 = DQK / 16, KP = DQK * 2, SHM_K = KVBLK * KP, KPT = DQK / 64, NKP = DQK / 8;
  int tid_ = TIDX; asm volatile("" : "+v"(tid_));
  const int tid = tid_, wid = tid >> 6, lane = tid & 63, r32 = lane & 31, hi = lane >> 5;
  char* V_lds = lds; char* K_lds = lds + K_OFF;
  float* ws = (float*)(lds + WS_OFF) + wid * 64; float* li_l = ws; float* al_l = ws + 32;
  const float C = scale * 1.4426950408889634f, thrS = THR / scale;
  float m_reg = -1e30f, l_reg = 0; f32x16 o[4] = {}; bf16x8 qr[ND0];
  const bf16* Qw = Qb + (long)(wid * QBLK + r32) * ldq + hi * 8;
#pragma unroll
  for (int d0 = 0; d0 < ND0; ++d0) qr[d0] = ld8(Qw + d0 * 16);
  const int sr = tid >> 4, sc = (tid & 15) * 8, vst0 = v_st(sr, sc), vst1 = v_st(32 + sr, sc);
  const int vg0 = sr * ldv + sc, vg1 = (32 + sr) * ldv + sc;
  int kst[KPT], kg[KPT];
#pragma unroll
  for (int i = 0; i < KPT; ++i) { const int p = tid + 512 * i, row = p / NKP, cp = p % NKP; kst[i] = KSWZ(KP, row, cp * 16); kg[i] = row * ldk + cp * 8; }
  const int vb0 = (int)(uintptr_t)V_lds + v_rd_base(lane);
  struct { bf16x8 vs0, vs1, ks[KPT]; } sr_[SDEPTH];
  const __amdgpu_buffer_rsrc_t rsK = __builtin_amdgcn_make_buffer_rsrc((void*)Kh, 0, 0x7fffffff, 0x00020000);
  const __amdgpu_buffer_rsrc_t rsV = __builtin_amdgcn_make_buffer_rsrc((void*)Vh, 0, 0x7fffffff, 0x00020000);
#define BLD(rs, voff, soff) __builtin_bit_cast(bf16x8, __builtin_amdgcn_raw_buffer_load_b128((rs), (voff), (soff), 0))
#define SLOAD(i, k0) do { const int sv_ = (k0) * (ldv * 2), sk_ = (k0) * (ldk * 2); sr_[i].vs0 = BLD(rsV, vg0 * 2, sv_); sr_[i].vs1 = BLD(rsV, vg1 * 2, sv_); \
    _Pragma("unroll") for (int q_ = 0; q_ < KPT; ++q_) sr_[i].ks[q_] = BLD(rsK, kg[q_] * 2, sk_); } while (0)
#define SWRITE(b, i) do { *(bf16x8*)(V_lds + (b) * SHM_V + vst0) = sr_[i].vs0; *(bf16x8*)(V_lds + (b) * SHM_V + vst1) = sr_[i].vs1; \
    _Pragma("unroll") for (int q_ = 0; q_ < KPT; ++q_) *(bf16x8*)(K_lds + (b) * SHM_K + kst[q_]) = sr_[i].ks[q_]; } while (0)
#define SWAIT() do { if constexpr (SDEPTH == 2) { if constexpr (KPT == 1) asm volatile("s_waitcnt vmcnt(3)" ::: "memory"); else if constexpr (KPT == 2) asm volatile("s_waitcnt vmcnt(4)" ::: "memory"); else asm volatile("s_waitcnt vmcnt(5)" ::: "memory"); } \
    else asm volatile("s_waitcnt vmcnt(0)" ::: "memory"); } while (0)
#define RESC(a) do { if constexpr (!FIXM) if (__any((a) < 1.f)) { if (hi == 0) al_l[r32] = (a); asm volatile("s_waitcnt lgkmcnt(0)" ::: "memory"); \
    _Pragma("unroll") for (int d = 0; d < 4; ++d) _Pragma("unroll") for (int r = 0; r < 16; ++r) o[d][r] *= al_l[crow(r, hi)]; } } while (0)
  f32x16 pA0, pA1, pB0, pB1; float mnA, mnB, alA, alB; bf16x8 pa0, pa1, pa2, pa3;
  if constexpr (PIPE == 0 && KVT2) {
    static_assert(SDEPTH == 2 && DQK <= 128, "double tiles need two staging slots and fit LDS only for DQK <= 128");
    const int nd = nt >> 1;
    SLOAD(0, 0); SLOAD(1, KVBLK); asm volatile("s_waitcnt vmcnt(0)" ::: "memory"); SWRITE(0, 0); SWRITE(1, 1); SLOAD(0, 2 * KVBLK); SLOAD(1, 3 * KVBLK);
    for (int jj = 0; jj < nd; ++jj) {
      const int b = jj & 1;
      __syncthreads();
      if (jj + 1 < nd) { SWRITE(2 * (b ^ 1), 0); SWRITE(2 * (b ^ 1) + 1, 1); }
      if (jj + 2 < nd) { SLOAD(0, (2 * jj + 4) * KVBLK); SLOAD(1, (2 * jj + 5) * KVBLK); }
#pragma unroll
      for (int sub = 0; sub < 2; ++sub) {
        const int sb = 2 * b + sub, kb = kb0 + (2 * jj + sub) * KVBLK;
        SBAR(); qkt<DQK>(pA0, pA1, K_lds + sb * SHM_K, qr, r32, hi); SBAR();
        const int vb = vb0 + sb * SHM_V;
        VF f0, f1; v_issue<0>(f0, vb);
        partialSM<FIXM>(pA0, pA1, m_reg, mnA, alA, C, thrS, kb, hi);
        RESC(alA);
        finishSM<FIXM>(pA0, pA1, alA, l_reg, pa0, pa1, pa2, pa3, kb, hi); SBAR();
        pv_pipe(o, vb, f0, f1, pa0, pa1, pa2, pa3);
      }
    }
  } else if constexpr (PIPE == 0 && !SPLIT && ATT_STEP) {
#define SLOADK(k0) do { const bf16* kp_ = Kh + (long)(k0) * ldk; _Pragma("unroll") for (int q_ = 0; q_ < KPT; ++q_) sr_[0].ks[q_] = ld8(kp_ + kg[q_]); } while (0)
#define SLOADV(k0) do { const bf16* vp_ = Vh + (long)(k0) * ldv; sr_[0].vs0 = ld8(vp_ + vg0); sr_[0].vs1 = ld8(vp_ + vg1); } while (0)
#define SWRITEK(b) do { _Pragma("unroll") for (int q_ = 0; q_ < KPT; ++q_) *(bf16x8*)(K_lds + (b) * SHM_K + kst[q_]) = sr_[0].ks[q_]; } while (0)
#define SWRITEV(b) do { *(bf16x8*)(V_lds + (b) * SHM_V + vst0) = sr_[0].vs0; *(bf16x8*)(V_lds + (b) * SHM_V + vst1) = sr_[0].vs1; } while (0)
    SLOADK(0); SLOADV(0); asm volatile("s_waitcnt vmcnt(0)" ::: "memory"); SWRITEK(0); SWRITEV(0); SLOADK(KVBLK); SLOADV(KVBLK);
    if (wave_s >= 4) __syncthreads();
    for (int j = 0; j < nt; ++j) {
      const int b = j & 1;
      __syncthreads();
      if (j + 1 < nt) { SWRITEK(b ^ 1); }
      if (j + 2 < nt) { SLOADK((j + 2) * KVBLK); }
      SBAR(); qkt<DQK>(pA0, pA1, K_lds + b * SHM_K, qr, r32, hi); SBAR();
      __syncthreads();
      if (j + 1 < nt) { SWRITEV(b ^ 1); }
      if (j + 2 < nt) { SLOADV((j + 2) * KVBLK); }
      { const int vb = vb0 + b * SHM_V, kb = kb0 + j * KVBLK;
        if constexpr (DQK != 192 && ATT_STEP_VPIPE) {
          VF f0, f1; v_issue<0>(f0, vb);
          partialSM<FIXM>(pA0, pA1, m_reg, mnA, alA, C, thrS, kb, hi); RESC(alA);
          finishSM<FIXM>(pA0, pA1, alA, l_reg, pa0, pa1, pa2, pa3, kb, hi); SBAR();
          pv_pipe(o, vb, f0, f1, pa0, pa1, pa2, pa3);
        } else {
          partialSM<FIXM>(pA0, pA1, m_reg, mnA, alA, C, thrS, kb, hi); RESC(alA);
          finishSM<FIXM>(pA0, pA1, alA, l_reg, pa0, pa1, pa2, pa3, kb, hi); SBAR();
          pv_d0(o, vb, pa0, pa1, pa2, pa3);
        } }
    }
    if (wave_s < 4) __syncthreads();
#undef SLOADK
#undef SLOADV
#undef SWRITEK
#undef SWRITEV
  } else if constexpr (PIPE == 0) {
    SLOAD(0, 0); asm volatile("s_waitcnt vmcnt(0)" ::: "memory"); SWRITE(0, 0); SLOAD(0, KVBLK);
    for (int j = 0; j < nt; ++j) {
      const int b = j & 1;
      __syncthreads();
      if constexpr (DQK == 64 && ATT_KEARLY) {
        bf16x8 ka[4], kq[4]; const char* Ks = K_lds + b * SHM_K;
#pragma unroll
        for (int d0 = 0; d0 < 4; ++d0) { const int cb = (d0 * 16 + hi * 8) * 2;
          ka[d0] = *reinterpret_cast<const bf16x8*>(Ks + KSWZ(KP, r32, cb)); kq[d0] = *reinterpret_cast<const bf16x8*>(Ks + KSWZ(KP, 32 + r32, cb)); }
        SBAR();
        if (j + 1 < nt) { SWRITE(b ^ 1, 0); }
        if (j + 2 < nt) { SLOAD(0, (j + 2) * KVBLK); }
        SBAR();
        pA0 = f32x16{}; pA1 = f32x16{};
#pragma unroll
        for (int d0 = 0; d0 < 4; ++d0) { pA0 = __builtin_amdgcn_mfma_f32_32x32x16_bf16(ka[d0], qr[d0], pA0, 0, 0, 0); pA1 = __builtin_amdgcn_mfma_f32_32x32x16_bf16(kq[d0], qr[d0], pA1, 0, 0, 0); }
        SBAR();
      } else {
      if (j + 1 < nt) { SWRITE(b ^ 1, 0); }
      if (j + 2 < nt) { SLOAD(0, (j + 2) * KVBLK); }
      SBAR(); qkt<DQK>(pA0, pA1, K_lds + b * SHM_K, qr, r32, hi); SBAR();
      }
      const int vb = vb0 + b * SHM_V;
      if constexpr (DQK != 192) {
        VF f0, f1; v_issue<0>(f0, vb);
        partialSM<FIXM>(pA0, pA1, m_reg, mnA, alA, C, thrS, kb0 + j * KVBLK, hi);
        RESC(alA);
        finishSM<FIXM>(pA0, pA1, alA, l_reg, pa0, pa1, pa2, pa3, kb0 + j * KVBLK, hi); SBAR();
        pv_pipe(o, vb, f0, f1, pa0, pa1, pa2, pa3);
      } else {
        partialSM<FIXM>(pA0, pA1, m_reg, mnA, alA, C, thrS, kb0 + j * KVBLK, hi);
        RESC(alA);
        finishSM<FIXM>(pA0, pA1, alA, l_reg, pa0, pa1, pa2, pa3, kb0 + j * KVBLK, hi); SBAR();
        pv_d0(o, vb, pa0, pa1, pa2, pa3);
      }
    }
  } else {
  constexpr int SE = 0, SO = SDEPTH - 1;
  SLOAD(SE, 0); asm volatile("s_waitcnt vmcnt(0)" ::: "memory"); SWRITE(0, SE); __syncthreads();
  qkt<DQK>(pA0, pA1, K_lds, qr, r32, hi); partialSM<FIXM>(pA0, pA1, m_reg, mnA, alA, C, thrS, kb0, hi);
  SLOAD(SO, KVBLK); if constexpr (SDEPTH == 2) { SLOAD(SE, 2 * KVBLK); }
  SWAIT(); SWRITE(1, SO); __syncthreads();
  for (int j = 1; j + 1 < nt; j += 2) {
    SBAR(); qkt<DQK>(pB0, pB1, K_lds + SHM_K, qr, r32, hi);
    finishSM<FIXM>(pA0, pA1, alA, l_reg, pa0, pa1, pa2, pa3, kb0 + (j - 1) * KVBLK, hi); SBAR();
    SLOAD(SO, (j + SDEPTH) * KVBLK); SBAR();
    pv_d0(o, vb0, pa0, pa1, pa2, pa3); partialSM<FIXM>(pB0, pB1, m_reg, mnB, alB, C, thrS, kb0 + j * KVBLK, hi);
    __syncthreads(); SWAIT(); SWRITE(0, SE);
    RESC(alB); __syncthreads();
    SBAR(); qkt<DQK>(pA0, pA1, K_lds, qr, r32, hi);
    finishSM<FIXM>(pB0, pB1, alB, l_reg, pa0, pa1, pa2, pa3, kb0 + j * KVBLK, hi); SBAR();
    if (SDEPTH == 1 || j + 3 < nt) SLOAD(SE, (j + 1 + SDEPTH) * KVBLK); SBAR();
    pv_d0(o, vb0 + SHM_V, pa0, pa1, pa2, pa3); partialSM<FIXM>(pA0, pA1, m_reg, mnA, alA, C, thrS, kb0 + (j + 1) * KVBLK, hi);
    __syncthreads(); SWAIT(); SWRITE(1, SO);
    RESC(alA); __syncthreads();
  }
  SBAR(); qkt<DQK>(pB0, pB1, K_lds + SHM_K, qr, r32, hi);
  finishSM<FIXM>(pA0, pA1, alA, l_reg, pa0, pa1, pa2, pa3, kb0 + (nt - 2) * KVBLK, hi); SBAR();
  pv_d0(o, vb0, pa0, pa1, pa2, pa3); partialSM<FIXM>(pB0, pB1, m_reg, mnB, alB, C, thrS, kb0 + (nt - 1) * KVBLK, hi);
  __syncthreads(); RESC(alB);
  finishSM<FIXM>(pB0, pB1, alB, l_reg, pa0, pa1, pa2, pa3, kb0 + (nt - 1) * KVBLK, hi); SBAR();
  pv_d0(o, vb0 + SHM_V, pa0, pa1, pa2, pa3);
  }
  { auto rr = __builtin_amdgcn_permlane32_swap(__float_as_uint(l_reg), __float_as_uint(l_reg), false, false);
    l_reg = __uint_as_float(rr[0]) + __uint_as_float(rr[1]); }
  if constexpr (SPLIT) if (part != nullptr) {
    if (wid == 0) {
#pragma unroll
      for (int r = 0; r < 16; ++r) { const int orow = crow(r, hi);
        if (orow < 16) {
#pragma unroll
          for (int d0 = 0; d0 < 4; ++d0) part[orow * 132 + d0 * 32 + r32] = o[d0][r]; } }
      if (hi == 0 && r32 < 16) { part[r32 * 132 + 128] = m_reg; part[r32 * 132 + 129] = l_reg; }
    }
    __syncthreads();
    return;
  }
  if (hi == 0) li_l[r32] = l_reg; asm volatile("s_waitcnt lgkmcnt(0)" ::: "memory");
#pragma unroll
  for (int r = 0; r < 16; ++r) { const int orow = wid * QBLK + crow(r, hi); const float rli = __builtin_amdgcn_rcpf(li_l[crow(r, hi)]);
    if (orow < nvalid) {
      if constexpr (MODE == 0) {
#pragma unroll
        for (int d0 = 0; d0 < 4; ++d0) Of[(long)orow * ldo + d0 * 32 + r32] = o[d0][r] * rli;
      } else {
#pragma unroll
        for (int d0 = 0; d0 < 4; ++d0) { const float g = bf2f(Gb[(long)orow * ldg + d0 * 32 + r32]); const float sg = g / (1.f + __expf(-g));
          Yb[(long)orow * ldy + d0 * 32 + r32] = (bf16)f2bf(o[d0][r] * rli * sg); }
      }
    } }
  __syncthreads();
#undef SLOAD
#undef SWRITE
#undef SWAIT
#undef RESC
}
}

#define LAS __attribute__((address_space(3)))
typedef unsigned short bf16_t;
typedef float f32x4 __attribute__((ext_vector_type(4)));
typedef unsigned u32x4 __attribute__((ext_vector_type(4)));
typedef unsigned u32x2 __attribute__((ext_vector_type(2)));
constexpr int DM = 2048, SEQ = 16384, NMETA = 16, LROWS = SEQ + NMETA, MP = 16640  , DEPTH = 2;
constexpr int INC = 5824, INP = 5888;
constexpr float EPS = 1e-6f;
constexpr int C_AQ = 0, C_AK = 512, C_AV = 1024, C_AG = 1536, C_BQ = 2048, C_BK = 2560, C_BV = 2816, C_BG = 3072,
              C_CQ = 3584, C_CKV = 3968, C_CKR = 4224, C_CG = 4288, C_DU = 4800, C_DG = 5312;
constexpr size_t MiB = 1u << 20;
constexpr size_t al256(size_t x) { return (x + 255) / 256 * 256; }
constexpr size_t WS_CTL = 0;
constexpr size_t WS_XMETA = 4096;
constexpr size_t WS_BAR = 256 * 1024;
constexpr size_t WS_PART = 512 * 1024;
constexpr size_t WS_WIN = 2 * MiB;
constexpr size_t WS_WOUT = WS_WIN + al256((size_t)DEPTH * INP * DM * 2);
constexpr size_t WS_WUQ = WS_WOUT + al256((size_t)DEPTH * DM * DM * 2);
constexpr size_t WS_WUKV = WS_WUQ + al256((size_t)DEPTH * 768 * 384 * 2);
constexpr size_t WS_WD = WS_WUKV + al256((size_t)DEPTH * 1024 * 256 * 2);
constexpr size_t WS_HY = WS_WD + al256((size_t)DEPTH * 512 * 512 * 2);
constexpr size_t WS_P = WS_HY + al256((size_t)MP * DM * 2);
constexpr size_t WS_POOL = WS_P + al256((size_t)MP * INP * 2);
constexpr size_t WS_QC = WS_POOL + al256((size_t)MP * 512 * 2);
constexpr size_t WS_KVC = WS_QC + al256((size_t)MP * 768 * 2);
constexpr size_t WS_KC = WS_KVC + al256((size_t)MP * 1024 * 2);
constexpr size_t WS_OA = WS_KC + al256((size_t)MP * 768 * 2);
constexpr size_t WS_END = WS_OA + al256((size_t)MP * 1024 * 4);

constexpr float LOG2E = 1.4426950408889634f, LN2 = 0.6931471805599453f;
constexpr float QS_A = 0.125f * LOG2E, QS_B = 0.08838834764831845f * LOG2E, QS_C = 0.07216878364870323f * LOG2E;
struct Params {
  const float *x, *meta, *norm_w, *w_in, *w_out, *a_q_norm, *a_k_norm, *a_lambda, *a_subln, *b_q_norm, *b_k_norm,
              *c_q_lat, *c_kv_lat, *c_w_uq, *c_w_ukv, *c_q_norm, *c_k_norm, *d_w_group, *d_scale;
  float* out; unsigned char* ws;
  float inv_a[8], inv_b[32], inv_c[32];
};

__device__ __forceinline__ float bf2f(unsigned short b) { return __uint_as_float((unsigned)b << 16); }
__device__ __forceinline__ float bflo(unsigned w) { return __uint_as_float(w << 16); }
__device__ __forceinline__ float bfhi(unsigned w) { return __uint_as_float(w & 0xffff0000u); }
__device__ __forceinline__ unsigned f2bf(float f) { unsigned u = __float_as_uint(f); return (u + 0x7fffu + ((u >> 16) & 1u)) >> 16; }
__device__ __forceinline__ unsigned pk2(float lo, float hi) { return f2bf(lo) | (f2bf(hi) << 16); }
__device__ __forceinline__ float silu(float g) { return g / (1.f + __expf(-g)); }
__device__ __forceinline__ float wave_sum(float v) {
#pragma unroll
  for (int o = 1; o < 64; o <<= 1) v += __shfl_xor(v, o);
  return v;
}
__device__ __forceinline__ float wave_max(float v) {
#pragma unroll
  for (int o = 1; o < 64; o <<= 1) v = fmaxf(v, __shfl_xor(v, o));
  return v;
}
__device__ __forceinline__ float sum16(float v) { v += __shfl_xor(v, 1); v += __shfl_xor(v, 2); v += __shfl_xor(v, 4); v += __shfl_xor(v, 8); return v; }
__device__ __forceinline__ void rope_cs(float pos, float inv, float& c, float& s) {
  const float ang = pos * inv;
  double rev = (double)ang * 0.15915494309189535; rev -= rint(rev);
  const float fr = (float)rev;
  s = __builtin_amdgcn_sinf(fr); c = __builtin_amdgcn_cosf(fr);
}
__device__ __forceinline__ void unpack8(const u32x4 w, float* x) { x[0] = bflo(w.x); x[1] = bfhi(w.x); x[2] = bflo(w.y); x[3] = bfhi(w.y); x[4] = bflo(w.z); x[5] = bfhi(w.z); x[6] = bflo(w.w); x[7] = bfhi(w.w); }
__device__ __forceinline__ u32x4 pack8(const float* x) { u32x4 w; w.x = pk2(x[0], x[1]); w.y = pk2(x[2], x[3]); w.z = pk2(x[4], x[5]); w.w = pk2(x[6], x[7]); return w; }

#define XB_TMO      128
#define XB_XCNT(j)  (256  + 64 * (j))
#define XB_XSUB(j)  (1280 + 64 * (j))
#define XB_XGEN(j)  (2304 + 64 * (j))
#define XB_TOP      3328
#define XB_TOPGEN   3392
#define XCD_BAR_WORDS 3456
#define XB_SPIN_CAP (1u << 18)

__device__ __forceinline__ unsigned xb_ld(unsigned* p)              { return __hip_atomic_load(p, __ATOMIC_RELAXED, __HIP_MEMORY_SCOPE_AGENT); }
__device__ __forceinline__ unsigned xb_add(unsigned* p, unsigned v) { return __hip_atomic_fetch_add(p, v, __ATOMIC_RELAXED, __HIP_MEMORY_SCOPE_AGENT); }
__device__ __forceinline__ unsigned xb_xcc_id() { return (unsigned)__builtin_amdgcn_s_getreg((3 << 11) | 20) & 0xFu; }
#define XB_SPIN(cond, bar) do { unsigned _sp = 0; while (cond) { __builtin_amdgcn_s_sleep(1); \
    if ((++_sp & 255u) == 0u) { if (xb_ld(&(bar)[XB_TMO])) break; if (_sp > XB_SPIN_CAP) { atomicAdd(&(bar)[XB_TMO], 1u); break; } } } } while (0)

struct XcdBarrier {
    unsigned* bar; unsigned x;
    volatile LAS unsigned* st;
};

__device__ __forceinline__ XcdBarrier xcd_barrier_post(unsigned* bar, volatile LAS unsigned* st, const int wave_s) {
    XcdBarrier b; b.bar = bar; b.x = xb_xcc_id(); b.st = st;
    if (TIDX == 0) (void)xb_add(&bar[XB_XCNT(b.x)], 1u);
    return b;
}
__device__ __forceinline__ void xcd_barrier_complete(unsigned* bar, unsigned x, unsigned& nloc, unsigned& nx) {
    const unsigned G = gridDim.x * gridDim.y * gridDim.z;
    unsigned sum, cnt, mine, sp = 0u;
    for (;;) {
        sum = 0u; cnt = 0u; mine = 0u;
#pragma unroll
        for (unsigned j = 0; j < 16; ++j) { const unsigned c = xb_ld(&bar[XB_XCNT(j)]); sum += c; cnt += (c > 0u) ? 1u : 0u; mine = (j == x) ? c : mine; }
        if (sum == G) break;
        __builtin_amdgcn_s_sleep(1);
        if ((++sp & 255u) == 0u) { if (xb_ld(&bar[XB_TMO])) break; if (sp > XB_SPIN_CAP) { atomicAdd(&bar[XB_TMO], 1u); break; } }
    }
    nloc = mine > 0u ? mine : 1u; nx = cnt > 0u ? cnt : 1u;
}

__device__ __forceinline__ void xcd_barrier(const XcdBarrier& b, const int wave_s) {
    asm volatile("s_waitcnt vmcnt(0)" ::: "memory");
    __syncthreads();
    if (TIDX == 0) {
        unsigned* bar = b.bar;
        __builtin_amdgcn_s_waitcnt(0);
        unsigned nloc = b.st[0], nx = b.st[1];
        if (nloc == 0u) { xcd_barrier_complete(bar, b.x, nloc, nx); b.st[0] = nloc; b.st[1] = nx; }
        const unsigned old = xb_add(&bar[XB_XSUB(b.x)], 1u);
        const unsigned gen = old / nloc;
        if (old + 1u == (gen + 1u) * nloc) {
            __builtin_amdgcn_fence(__ATOMIC_RELEASE, "agent");
            asm volatile("s_waitcnt vmcnt(0)" ::: "memory");
            const unsigned og = xb_add(&bar[XB_TOP], 1u);
            const unsigned tg = og / nx;
            if (og + 1u == (tg + 1u) * nx) xb_add(&bar[XB_TOPGEN], 1u);
            else XB_SPIN(xb_ld(&bar[XB_TOPGEN]) == tg, bar);
            __builtin_amdgcn_fence(__ATOMIC_ACQUIRE, "agent");
            xb_add(&bar[XB_XGEN(b.x)], 1u);
            asm volatile("s_waitcnt vmcnt(0)" ::: "memory");
        } else {
            XB_SPIN(xb_ld(&bar[XB_XGEN(b.x)]) == gen, bar);
            __builtin_amdgcn_fence(__ATOMIC_ACQUIRE, "agent");
            asm volatile("s_waitcnt vmcnt(0)" ::: "memory");
        }
    }
    __syncthreads();
}

__device__ __forceinline__ void tr_item(const float* __restrict__ W, int ldw, int sk0, int sn0, bf16_t* __restrict__ WT, int ldt, int dn0, int dk0, LAS float* scr, int lane, bool zero) {
  if (!zero) {
#pragma unroll 8
    for (int i = 0; i < 32; ++i) { const int kk = 2 * i + (lane >> 5); scr[kk * 33 + (lane & 31)] = W[(size_t)(sk0 + kk) * ldw + sn0 + (lane & 31)]; }
  }
  asm volatile("s_waitcnt lgkmcnt(0)" ::: "memory");
  const int c = lane & 7;
#pragma unroll
  for (int j = 0; j < 4; ++j) { const int n = (lane >> 3) + 8 * j; const LAS float* s = scr + (8 * c) * 33 + n;
    u32x4 o = {0u, 0u, 0u, 0u};
    if (!zero) { o.x = pk2(s[0 * 33], s[1 * 33]); o.y = pk2(s[2 * 33], s[3 * 33]); o.z = pk2(s[4 * 33], s[5 * 33]); o.w = pk2(s[6 * 33], s[7 * 33]); }
    *(u32x4*)(WT + (size_t)(dn0 + n) * ldt + dk0 + 8 * c) = o; }
  asm volatile("s_waitcnt lgkmcnt(0)" ::: "memory");
}

__device__ __forceinline__ void phase_prologue(const Params& p, LAS unsigned char* lds, const int wave_s) {
  int t_ = TIDX; asm volatile("" : "+v"(t_)); const int lane = t_ & 63, wave = __builtin_amdgcn_readfirstlane(t_ >> 6), gw = blockIdx.x * 8 + wave, NGW = gridDim.x * 8; (void)wave;
  LAS float* scr = (LAS float*)(lds + wave * 16384);
  unsigned char* ws = p.ws;
  constexpr int I_IN = (DM / 64) * (INC / 32), I_OUT = (DM / 64) * (DM / 32), I_UQ = (384 / 64) * (768 / 32), I_UKV = (256 / 64) * (1024 / 32), I_D = (512 / 64) * (512 / 32);
  constexpr int I_LAYER = I_IN + I_OUT + I_UQ + I_UKV + I_D;
  for (int it = gw; it < DEPTH * I_LAYER; it += NGW) {
    const int layer = it / I_LAYER; int r = it % I_LAYER;
    if (r < I_IN) { const int nblk = INC / 32, kb = r / nblk, nb = r % nblk;
      tr_item(p.w_in + (size_t)layer * DM * INC, INC, 64 * kb, 32 * nb, (bf16_t*)(ws + WS_WIN) + (size_t)layer * INP * DM, DM, 32 * nb, 64 * kb, scr, lane, false); continue; } r -= I_IN;
    if (r < I_OUT) { const int nblk = DM / 32, kb = r / nblk, nb = r % nblk;
      tr_item(p.w_out + (size_t)layer * DM * DM, DM, 64 * kb, 32 * nb, (bf16_t*)(ws + WS_WOUT) + (size_t)layer * DM * DM, DM, 32 * nb, 64 * kb, scr, lane, false); continue; } r -= I_OUT;
    if (r < I_UQ) { const int nblk = 768 / 32, kb = r / nblk, nb = r % nblk;
      tr_item(p.c_w_uq + (size_t)layer * 384 * 768, 768, 64 * kb, 32 * nb, (bf16_t*)(ws + WS_WUQ) + (size_t)layer * 768 * 384, 384, 32 * nb, 64 * kb, scr, lane, false); continue; } r -= I_UQ;
    if (r < I_UKV) { const int nblk = 1024 / 32, kb = r / nblk, nb = r % nblk;
      tr_item(p.c_w_ukv + (size_t)layer * 256 * 1024, 1024, 64 * kb, 32 * nb, (bf16_t*)(ws + WS_WUKV) + (size_t)layer * 1024 * 256, 256, 32 * nb, 64 * kb, scr, lane, false); continue; } r -= I_UKV;
    { const int nblk = 512 / 32, kb = r / nblk, nb = r % nblk, k0 = 64 * kb, n0 = 32 * nb, gk = k0 >> 7, gn = n0 >> 7;
      tr_item(p.d_w_group + ((size_t)layer * 4 + gk) * 128 * 128, 128, k0 & 127, n0 & 127, (bf16_t*)(ws + WS_WD) + (size_t)layer * 512 * 512, 512, n0, k0, scr, lane, gk != gn); }
  }
  for (int i = gw * 64 + lane; i < DEPTH * (INP - INC) * DM / 8; i += NGW * 64) { const int layer = i / ((INP - INC) * DM / 8), j = i % ((INP - INC) * DM / 8);
    *(u32x4*)((bf16_t*)(ws + WS_WIN) + (size_t)layer * INP * DM + (size_t)INC * DM + (size_t)j * 8) = (u32x4){0u, 0u, 0u, 0u}; }
  if (gw == 0) { ((unsigned*)(ws + WS_CTL))[lane] = 0u; ((unsigned*)(ws + WS_CTL))[64 + lane] = 0u; }
  if (gw < DEPTH) { const int layer = gw, ln = lane; int fastmask;
    const float* aqn = p.a_q_norm + layer * 64; const float* akn = p.a_k_norm + layer * 64; const float* bqn = p.b_q_norm + layer * 128; const float* bkn = p.b_k_norm + layer * 128;
    const float* cqn = p.c_q_norm + layer * 192; const float* ckn = p.c_k_norm + layer * 192;
    const float maq = wave_max(fabsf(aqn[ln])), mak = wave_max(fabsf(akn[ln]));
    const float mbq = wave_max(fmaxf(fabsf(bqn[ln]), fabsf(bqn[64 + ln]))), mbk = wave_max(fmaxf(fabsf(bkn[ln]), fabsf(bkn[64 + ln])));
    const float mcqn = wave_max(fmaxf(fabsf(cqn[ln]), fabsf(cqn[64 + ln]))), mcqr = wave_max(fabsf(cqn[128 + ln]));
    const float mckn = wave_max(fmaxf(fabsf(ckn[ln]), fabsf(ckn[64 + ln]))), mckr = wave_max(fabsf(ckn[128 + ln]));
    const float bA = 64.f * maq * mak * QS_A, bB = 128.f * mbq * mbk * QS_B;
    const float bC = sqrtf((128.f * mcqn * mcqn + 64.f * mcqr * mcqr) * (128.f * mckn * mckn + 64.f * mckr * mckr)) * QS_C;
    fastmask = (bC < 60.f ? 1 : 0) | (bB < 60.f ? 2 : 0) | (bA < 60.f ? 4 : 0);
    if (lane == 0) ((int*)(ws + WS_CTL))[256 + layer] = fastmask; }

  if (blockIdx.x == 0) { for (int i = t_; i < XCD_BAR_WORDS; i += 512) ((unsigned*)(ws + WS_BAR))[i] = 0u; }
}

__device__ __forceinline__ void phase_rmsnorm(const float* __restrict__ src_meta, const float* __restrict__ src_body, const float* __restrict__ w, bf16_t* __restrict__ H, const int wave_s) {
  int t_ = TIDX; asm volatile("" : "+v"(t_)); const int lane = t_ & 63, wave = __builtin_amdgcn_readfirstlane(t_ >> 6), gw = blockIdx.x * 8 + wave, NGW = gridDim.x * 8; (void)wave;
  for (int r = gw; r < MP; r += NGW) {
    u32x2* o8 = (u32x2*)(H + (size_t)r * DM) + lane;
    if (r >= LROWS) {
#pragma unroll
      for (int j = 0; j < 8; ++j) o8[64 * j] = (u32x2){0u, 0u};
      continue; }
    const float* row = (r < NMETA) ? src_meta + (size_t)r * DM : src_body + (size_t)(r - NMETA) * DM;
    const f32x4* xr = (const f32x4*)row + lane; f32x4 v[8]; float ss = 0.f;
#pragma unroll
    for (int j = 0; j < 8; ++j) { v[j] = xr[64 * j]; ss += (v[j].x * v[j].x + v[j].y * v[j].y) + (v[j].z * v[j].z + v[j].w * v[j].w); }
    const float rs = rsqrtf(wave_sum(ss) * (1.f / DM) + EPS);
#pragma unroll
    for (int j = 0; j < 8; ++j) { const f32x4 g = ((const f32x4*)w)[lane + 64 * j];
      o8[64 * j] = (u32x2){pk2(v[j].x * rs * g.x, v[j].y * rs * g.y), pk2(v[j].z * rs * g.z, v[j].w * rs * g.w)}; }
  }
}

__device__ __forceinline__ void phase_post1(const Params& p, int layer, const int wave_s) {
  int t_ = TIDX; asm volatile("" : "+v"(t_)); const int lane = t_ & 63, wave = __builtin_amdgcn_readfirstlane(t_ >> 6), gw = blockIdx.x * 8 + wave, NGW = gridDim.x * 8; (void)wave;
  bf16_t* P = (bf16_t*)(p.ws + WS_P); bf16_t* POOL = (bf16_t*)(p.ws + WS_POOL); bf16_t* KC = (bf16_t*)(p.ws + WS_KC);
  const float* aqn = p.a_q_norm + layer * 64; const float* akn = p.a_k_norm + layer * 64;
  const float* bqn = p.b_q_norm + layer * 128; const float* bkn = p.b_k_norm + layer * 128;
  const float* cql = p.c_q_lat + layer * 384; const float* ckvl = p.c_kv_lat + layer * 256; const float* ckn = p.c_k_norm + layer * 192;
  for (int r = gw; r < MP; r += NGW) {
    if (r >= LROWS) {
      *(u32x4*)(POOL + (size_t)r * 512 + lane * 8) = (u32x4){0u, 0u, 0u, 0u};
      for (int i = lane; i < 768 / 8; i += 64) *(u32x4*)(KC + (size_t)r * 768 + i * 8) = (u32x4){0u, 0u, 0u, 0u};
      continue; }
    bf16_t* pr = P + (size_t)r * INP;
    const float posf = (float)r;
    const float rowp = (r < NMETA) ? -1.f : (float)((r - NMETA) >> 6), colp = (r < NMETA) ? (float)r : (float)((r - NMETA) & 63);
    { float x[16]; u32x4* ptr = (u32x4*)(pr + C_AQ + lane * 16); const u32x4 w0 = ptr[0], w1 = ptr[1]; unpack8(w0, x); unpack8(w1, x + 8);
      float ss = 0.f;
#pragma unroll
      for (int i = 0; i < 16; ++i) ss += x[i] * x[i];
      ss += __shfl_xor(ss, 1); ss += __shfl_xor(ss, 2);
      const float rs = rsqrtf(ss * (1.f / 64.f) + EPS) * ((lane >> 5) ? 1.f : QS_A);
      const float* wn = ((lane >> 5) ? akn : aqn) + (lane & 3) * 16;
#pragma unroll
      for (int i = 0; i < 16; ++i) x[i] = x[i] * rs * wn[i];
      if ((lane & 3) == 0) {
#pragma unroll
        for (int j = 0; j < 8; ++j) { float c, s; rope_cs(posf, p.inv_a[j], c, s); const float x1 = x[j], x2 = x[8 + j]; x[j] = x1 * c - x2 * s; x[8 + j] = x1 * s + x2 * c; }
      }
      ptr[0] = pack8(x); ptr[1] = pack8(x + 8); }
#pragma unroll
    for (int pass = 0; pass < 2; ++pass) {
      const bool act = (pass == 0) || (lane < 32);
      u32x4* ptr = (u32x4*)(pr + (pass == 0 ? C_BQ : C_BK) + lane * 8);
      float x[8]; u32x4 w = {0u, 0u, 0u, 0u}; if (act) w = *ptr; unpack8(w, x);
      float ss = 0.f;
#pragma unroll
      for (int i = 0; i < 8; ++i) ss += x[i] * x[i];
      ss = sum16(ss);
      const float rs = rsqrtf(ss * (1.f / 128.f) + EPS) * (pass == 0 ? QS_B : 1.f);
      const int a = lane & 15; const float* wn = (pass == 0 ? bqn : bkn) + a * 8;
      const float posv = (a < 8) ? rowp : colp;
#pragma unroll
      for (int i = 0; i < 8; ++i) { const float y = x[i] * rs * wn[i]; const float other = __shfl_xor(y, 4);
        float c, s; rope_cs(posv, p.inv_b[(a & 3) * 8 + i], c, s);
        x[i] = (a & 4) ? other * s + y * c : y * c - other * s; }
      if (act) *ptr = pack8(x);
    }
    { unsigned* ptr = (unsigned*)(pr + C_CQ); unsigned w[3]; float ss = 0.f;
#pragma unroll
      for (int j = 0; j < 3; ++j) { w[j] = ptr[lane + 64 * j]; const float a = bflo(w[j]), b = bfhi(w[j]); ss += a * a + b * b; }
      const float rs = rsqrtf(wave_sum(ss) * (1.f / 384.f) + EPS);
#pragma unroll
      for (int j = 0; j < 3; ++j) { const int e = 2 * (lane + 64 * j); ptr[lane + 64 * j] = pk2(bflo(w[j]) * rs * cql[e], bfhi(w[j]) * rs * cql[e + 1]); } }
    { u32x2* ptr = (u32x2*)(pr + C_CKV) + lane; const u32x2 w = *ptr; const float a0 = bflo(w.x), a1 = bfhi(w.x), a2 = bflo(w.y), a3 = bfhi(w.y);
      const float rs = rsqrtf(wave_sum(a0 * a0 + a1 * a1 + a2 * a2 + a3 * a3) * (1.f / 256.f) + EPS);
      const float* g = ckvl + lane * 4;
      *ptr = (u32x2){pk2(a0 * rs * g[0], a1 * rs * g[1]), pk2(a2 * rs * g[2], a3 * rs * g[3])}; }
    { const float xk = bf2f(pr[C_CKR + lane]); const float rs = rsqrtf(wave_sum(xk * xk) * (1.f / 64.f) + EPS);
      const float y = xk * rs * ckn[128 + lane]; const float other = __shfl_xor(y, 32);
      float c, s; rope_cs(posf, p.inv_c[lane & 31], c, s);
      const float o = (lane & 32) ? other * s + y * c : y * c - other * s; const bf16_t ob = (bf16_t)f2bf(o);
#pragma unroll
      for (int h = 0; h < 4; ++h) KC[(size_t)r * 768 + h * 192 + 128 + lane] = ob; }
    { const int hw = 1 << (lane >> 4); const int lo = max(r - hw, 0), hi = min(r + hw, LROWS);
      float acc[8], u[8];
#pragma unroll
      for (int i = 0; i < 8; ++i) acc[i] = 0.f;
      u32x4 wv[16];
#pragma unroll
      for (int j = 0; j < 16; ++j) { const int t = min(max(r - 8 + j, 0), LROWS - 1); wv[j] = *(const u32x4*)(P + (size_t)t * INP + C_DU + lane * 8); }
#pragma unroll
      for (int j = 0; j < 16; ++j) { const int t = r - 8 + j; float x[8]; unpack8(wv[j], x); const bool in = (t >= lo) && (t < hi);
#pragma unroll
        for (int i = 0; i < 8; ++i) acc[i] += in ? x[i] : 0.f;
        if (j == 8) {
#pragma unroll
          for (int i = 0; i < 8; ++i) u[i] = x[i]; } }
      const float inv = 1.f / (float)(hi - lo);
#pragma unroll
      for (int i = 0; i < 8; ++i) acc[i] = acc[i] * inv - u[i];
      *(u32x4*)(POOL + (size_t)r * 512 + lane * 8) = pack8(acc); }
  }
}

__device__ __forceinline__ void phase_post2(const Params& p, int layer, const int wave_s) {
  int t_ = TIDX; asm volatile("" : "+v"(t_)); const int lane = t_ & 63, wave = __builtin_amdgcn_readfirstlane(t_ >> 6), gw = blockIdx.x * 8 + wave, NGW = gridDim.x * 8; (void)wave;
  bf16_t* QC = (bf16_t*)(p.ws + WS_QC); const bf16_t* KVC = (const bf16_t*)(p.ws + WS_KVC); bf16_t* KC = (bf16_t*)(p.ws + WS_KC);
  const float* cqn = p.c_q_norm + layer * 192; const float* ckn = p.c_k_norm + layer * 192;
  const int h = lane >> 4, a = lane & 15;
  for (int r = gw; r < LROWS; r += NGW) {
    const float posf = (float)r;
    { u32x4* ptr = (u32x4*)(QC + (size_t)r * 768 + h * 192 + a * 8); float x[8]; unpack8(*ptr, x); float ss = 0.f;
#pragma unroll
      for (int i = 0; i < 8; ++i) ss += x[i] * x[i];
      const float rs = rsqrtf(sum16(ss) * (1.f / 128.f) + EPS) * QS_C;
#pragma unroll
      for (int i = 0; i < 8; ++i) x[i] = x[i] * rs * cqn[a * 8 + i];
      *ptr = pack8(x); }
    { u32x2* ptr = (u32x2*)(QC + (size_t)r * 768 + h * 192 + 128 + a * 4); const u32x2 w = *ptr; float x[4] = {bflo(w.x), bfhi(w.x), bflo(w.y), bfhi(w.y)};
      const float rs = rsqrtf(sum16(x[0] * x[0] + x[1] * x[1] + x[2] * x[2] + x[3] * x[3]) * (1.f / 64.f) + EPS) * QS_C;
#pragma unroll
      for (int i = 0; i < 4; ++i) { const float y = x[i] * rs * cqn[128 + a * 4 + i]; const float other = __shfl_xor(y, 8);
        float c, s; rope_cs(posf, p.inv_c[(a & 7) * 4 + i], c, s);
        x[i] = (a & 8) ? other * s + y * c : y * c - other * s; }
      *ptr = (u32x2){pk2(x[0], x[1]), pk2(x[2], x[3])}; }
    { float x[8]; unpack8(*(const u32x4*)(KVC + (size_t)r * 1024 + h * 256 + a * 8), x); float ss = 0.f;
#pragma unroll
      for (int i = 0; i < 8; ++i) ss += x[i] * x[i];
      const float rs = rsqrtf(sum16(ss) * (1.f / 128.f) + EPS);
#pragma unroll
      for (int i = 0; i < 8; ++i) x[i] = x[i] * rs * ckn[a * 8 + i];
      *(u32x4*)(KC + (size_t)r * 768 + h * 192 + a * 8) = pack8(x); }
  }
}

__device__ __forceinline__ void meta_combine8(const float* __restrict__ ph, int r, int col0, float C, float* out) {
  float M = -1e30f;
#pragma unroll
  for (int sidx = 0; sidx < 8; ++sidx) M = fmaxf(M, ph[(sidx * 16 + r) * 132 + 128]);
  float l = 0.f, acc[8];
#pragma unroll
  for (int i = 0; i < 8; ++i) acc[i] = 0.f;
#pragma unroll
  for (int sidx = 0; sidx < 8; ++sidx) { const float* pp = ph + (sidx * 16 + r) * 132; const float w = exp2f((pp[128] - M) * C); l += pp[129] * w;
    const f32x4 a = *(const f32x4*)(pp + col0), b = *(const f32x4*)(pp + col0 + 4);
    acc[0] += a.x * w; acc[1] += a.y * w; acc[2] += a.z * w; acc[3] += a.w * w; acc[4] += b.x * w; acc[5] += b.y * w; acc[6] += b.z * w; acc[7] += b.w * w; }
  const float il = 1.f / l;
#pragma unroll
  for (int i = 0; i < 8; ++i) out[i] = acc[i] * il;
}

__device__ __forceinline__ void phase_post3(const Params& p, int layer, float lambda_init, const int wave_s) {
  int t_ = TIDX; asm volatile("" : "+v"(t_)); const int lane = t_ & 63, wave = __builtin_amdgcn_readfirstlane(t_ >> 6), gw = blockIdx.x * 8 + wave, NGW = gridDim.x * 8; (void)wave;
  const bf16_t* P = (const bf16_t*)(p.ws + WS_P); const float* OA = (const float*)(p.ws + WS_OA); bf16_t* Y = (bf16_t*)(p.ws + WS_HY);
  const float* lp = p.a_lambda + layer * 256; const float* sub = p.a_subln + layer * 128; const float* dsc = p.d_scale + layer * 512;
  const float lam = __expf(wave_sum(lp[lane] * lp[64 + lane])) - __expf(wave_sum(lp[128 + lane] * lp[192 + lane])) + lambda_init;
  const float post = 1.f - lambda_init;
  const int h = lane >> 4, a = lane & 15;
  const bool metasplit = (layer != DEPTH - 1);
  const float* PART = (const float*)(p.ws + WS_PART);
  for (int r = gw; r < LROWS; r += NGW) {
    if (metasplit && r < NMETA) {
      float x1[8], x2[8];
      meta_combine8(PART + (size_t)((8 + 2 * h) * 8 * 16) * 132, r, a * 8, 1.f, x1);
      meta_combine8(PART + (size_t)((8 + 2 * h + 1) * 8 * 16) * 132, r, a * 8, 1.f, x2);
      float x[8], ss = 0.f;
#pragma unroll
      for (int i = 0; i < 8; ++i) { x[i] = x1[i] - lam * x2[i]; ss += x[i] * x[i]; }
      const float rs = rsqrtf(sum16(ss) * (1.f / 128.f) + EPS);
      float g[8]; unpack8(*(const u32x4*)(P + (size_t)r * INP + C_AG + h * 128 + a * 8), g);
#pragma unroll
      for (int i = 0; i < 8; ++i) x[i] = x[i] * rs * sub[a * 8 + i] * post * silu(g[i]);
      *(u32x4*)(Y + (size_t)r * DM + h * 128 + a * 8) = pack8(x);
      meta_combine8(PART + (size_t)((4 + h) * 8 * 16) * 132, r, a * 8, 1.f, x1);
      unpack8(*(const u32x4*)(P + (size_t)r * INP + C_BG + h * 128 + a * 8), g);
#pragma unroll
      for (int i = 0; i < 8; ++i) x1[i] *= silu(g[i]);
      *(u32x4*)(Y + (size_t)r * DM + 512 + h * 128 + a * 8) = pack8(x1);
      meta_combine8(PART + (size_t)(h * 8 * 16) * 132, r, a * 8, 1.f, x2);
      unpack8(*(const u32x4*)(P + (size_t)r * INP + C_CG + h * 128 + a * 8), g);
#pragma unroll
      for (int i = 0; i < 8; ++i) x2[i] *= silu(g[i]);
      *(u32x4*)(Y + (size_t)r * DM + 1024 + h * 128 + a * 8) = pack8(x2);
    } else
    { const f32x4* o1 = (const f32x4*)(OA + (size_t)r * 1024 + (2 * h) * 128 + a * 8); const f32x4* o2 = (const f32x4*)(OA + (size_t)r * 1024 + (2 * h + 1) * 128 + a * 8);
      const f32x4 u0 = o1[0], u1 = o1[1], v0 = o2[0], v1 = o2[1];
      float x[8] = {u0.x - lam * v0.x, u0.y - lam * v0.y, u0.z - lam * v0.z, u0.w - lam * v0.w, u1.x - lam * v1.x, u1.y - lam * v1.y, u1.z - lam * v1.z, u1.w - lam * v1.w};
      float ss = 0.f;
#pragma unroll
      for (int i = 0; i < 8; ++i) ss += x[i] * x[i];
      const float rs = rsqrtf(sum16(ss) * (1.f / 128.f) + EPS);
      float g[8]; unpack8(*(const u32x4*)(P + (size_t)r * INP + C_AG + h * 128 + a * 8), g);
#pragma unroll
      for (int i = 0; i < 8; ++i) x[i] = x[i] * rs * sub[a * 8 + i] * post * silu(g[i]);
      *(u32x4*)(Y + (size_t)r * DM + h * 128 + a * 8) = pack8(x); }
    { float m[8], g[8]; unpack8(*(const u32x4*)(P + (size_t)r * INP + C_DU + lane * 8), m); unpack8(*(const u32x4*)(P + (size_t)r * INP + C_DG + lane * 8), g);
#pragma unroll
      for (int i = 0; i < 8; ++i) m[i] = m[i] * dsc[lane * 8 + i] * silu(g[i]);
      *(u32x4*)(Y + (size_t)r * DM + 1536 + lane * 8) = pack8(m); }
  }
}

#ifndef ATT_SD128
#define ATT_SD128 1
#endif
#ifndef ATT_KVT2_A
#define ATT_KVT2_A 0
#endif
#ifndef ATT_KVT2_B
#define ATT_KVT2_B 0
#endif
#ifndef ATT_STEP_VPIPE
#define ATT_STEP_VPIPE 1
#endif
#ifndef ATT_PIPE64
#define ATT_PIPE64 0
#endif
#ifndef ATT_PIPE128
#define ATT_PIPE128 0
#endif
#ifndef ATT_SD192
#define ATT_SD192 1
#endif
#ifndef ATT_PIPE192
#define ATT_PIPE192 0
#endif
__device__ __forceinline__ void phase_attn(const Params& p, int layer, char* lds, int slot, const int wave_s) {
  const bf16_t* P = (const bf16_t*)(p.ws + WS_P); const bf16_t* QC = (const bf16_t*)(p.ws + WS_QC); const bf16_t* KVC = (const bf16_t*)(p.ws + WS_KVC);
  const bf16_t* KC = (const bf16_t*)(p.ws + WS_KC); float* OA = (float*)(p.ws + WS_OA); bf16_t* Y = (bf16_t*)(p.ws + WS_HY);
  unsigned* ctr = (unsigned*)(p.ws + WS_CTL) + slot * 16;
  volatile int* sh = (volatile int*)(lds + att::ATT_LDS);
  const int fastmask = __builtin_amdgcn_readfirstlane(((const int*)(p.ws + WS_CTL))[256 + layer]);
  const int QLEN = (layer == DEPTH - 1) ? 128 : 144;
  float* PART = (float*)(p.ws + WS_PART);
  int q = (int)(__builtin_amdgcn_s_getreg((3 << 11) | 20) & 7u), tried = 0;
  for (;;) {
    __syncthreads();
    if (TIDX == 0) { int u = -1;
      while (tried < 8) { u = (int)__hip_atomic_fetch_add(ctr + q, 1u, __ATOMIC_RELAXED, __HIP_MEMORY_SCOPE_AGENT); if (u < QLEN) break; u = -1; q = (q + 1) & 7; ++tried; }
      sh[0] = u; sh[1] = q; }
    __syncthreads();
    const int u = __builtin_amdgcn_readfirstlane(sh[0]), qx = __builtin_amdgcn_readfirstlane(sh[1]);
    if (u < 0) break;
    int type, h, qb, sp = -1; float* part = nullptr;
    if (u < 128) { const int seg = u >> 5, i = u & 31; if (seg < 2) { type = seg; h = qx >> 1; qb = 32 * (qx & 1) + i; } else { type = 2; h = qx; qb = 32 * (seg - 2) + i; } }
    else { const int m = qx * 16 + (u - 128), hd = m >> 3; sp = m & 7; qb = 64; if (hd < 4) { type = 0; h = hd; } else if (hd < 8) { type = 1; h = hd - 4; } else { type = 2; h = hd - 8; }
      part = PART + (size_t)(m * 16) * 132; }
    const int q0 = qb < 64 ? NMETA + 256 * qb : 0, nv = qb < 64 ? 256 : NMETA;
    const int kb0 = sp < 0 ? 0 : sp * 2048, nt = sp < 0 ? att::NT : (sp == 7 ? att::NT - 7 * 32 : 32);
    if (part != nullptr || !((fastmask >> type) & 1)) {
      if (type == 0) att::attn_unit<192, 1, 1, 0, 768, 768, 1024, 0, DM, INP, true>(wave_s, QC + (size_t)q0 * 768 + h * 192, KC + h * 192, KVC + h * 256 + 128, LN2, nv,
                                nullptr, Y + (size_t)q0 * DM + 1024 + h * 128, P + (size_t)q0 * INP + C_CG + h * 128, lds, kb0, nt, part);
      else if (type == 1) att::attn_unit<128, 1, 1, 0, INP, INP, INP, 0, DM, INP, true>(wave_s, P + (size_t)q0 * INP + C_BQ + h * 128, P + C_BK + (h >> 1) * 128, P + C_BV + (h >> 1) * 128, LN2, nv,
                                nullptr, Y + (size_t)q0 * DM + 512 + h * 128, P + (size_t)q0 * INP + C_BG + h * 128, lds, kb0, nt, part);
      else att::attn_unit<64, 1, 0, 0, INP, INP, INP, 1024, 0, 0, true>(wave_s, P + (size_t)q0 * INP + C_AQ + h * 64, P + C_AK + h * 64, P + C_AV + (h >> 1) * 128, LN2, nv,
                               OA + (size_t)q0 * 1024 + h * 128, nullptr, nullptr, lds, kb0, nt, part);
    } else if (type == 0) {
      att::attn_unit<192, ATT_SD192, 1, ATT_PIPE192, 768, 768, 1024, 0, DM, INP, false, true>(wave_s, QC + (size_t)q0 * 768 + h * 192, KC + h * 192, KVC + h * 256 + 128, LN2, nv,
                                nullptr, Y + (size_t)q0 * DM + 1024 + h * 128, P + (size_t)q0 * INP + C_CG + h * 128, lds);
    } else if (type == 1) {
      att::attn_unit<128, 1 + ATT_KVT2_B, 1, ATT_PIPE128, INP, INP, INP, 0, DM, INP, false, true, ATT_KVT2_B != 0>(wave_s, P + (size_t)q0 * INP + C_BQ + h * 128, P + C_BK + (h >> 1) * 128, P + C_BV + (h >> 1) * 128, LN2, nv,
                                nullptr, Y + (size_t)q0 * DM + 512 + h * 128, P + (size_t)q0 * INP + C_BG + h * 128, lds);
    } else {
      att::attn_unit<64, 1 + ATT_KVT2_A, 0, ATT_PIPE64, INP, INP, INP, 1024, 0, 0, false, true, ATT_KVT2_A != 0>(wave_s, P + (size_t)q0 * INP + C_AQ + h * 64, P + C_AK + h * 64, P + C_AV + (h >> 1) * 128, LN2, nv,
                               OA + (size_t)q0 * 1024 + h * 128, nullptr, nullptr, lds);
    }
  }
}

typedef short bf16x8_t __attribute__((ext_vector_type(8)));
template <class F>
__device__ __forceinline__ void small_gemm16(const bf16_t* __restrict__ A, const int lda, const bf16_t* __restrict__ Bt, const int N, const int K, const F& store, LAS unsigned char* lds, const int wave_s) {
  int t_ = TIDX; asm volatile("" : "+v"(t_)); const int lane = t_ & 63; const int G = gridDim.x;
  LAS f32x4* red = (LAS f32x4*)lds;
  const int kpw = K >> 3, k0 = wave_s * kpw;
  for (int blk = (int)blockIdx.x; blk < N / 16; blk += G) {
    f32x4 acc = {0.f, 0.f, 0.f, 0.f};
    const bf16_t* ap = A + (size_t)(lane & 15) * lda + (lane >> 4) * 8 + k0;
    const bf16_t* bp = Bt + (size_t)(blk * 16 + (lane & 15)) * K + (lane >> 4) * 8 + k0;
#pragma unroll 8
    for (int k = 0; k < kpw; k += 32) acc = __builtin_amdgcn_mfma_f32_16x16x32_bf16(*(const bf16x8_t*)(ap + k), *(const bf16x8_t*)(bp + k), acc, 0, 0, 0);
    red[wave_s * 64 + lane] = acc;
    __syncthreads();
    if (wave_s == 0) {
      f32x4 t = red[lane];
#pragma unroll
      for (int w = 1; w < 8; ++w) t += red[w * 64 + lane];
#pragma unroll
      for (int j = 0; j < 4; ++j) store(4 * (lane >> 4) + j, blk * 16 + (lane & 15), t[j]);
    }
    __syncthreads();
  }
}

constexpr int LDS_BYTES = 147456;
__global__ void __launch_bounds__(512, 2) hybrid_fwd(Params p) {
  extern __shared__ __attribute__((aligned(16))) unsigned char lds[];
  cg::grid_group grid = cg::this_grid();
  const int G = gridDim.x;
  const int wave_s = __builtin_amdgcn_readfirstlane((int)__builtin_amdgcn_workitem_id_x() >> 6);
  LAS unsigned char* ldsl = (LAS unsigned char*)lds;
  unsigned char* ws = p.ws;
  bf16_t* HY = (bf16_t*)(ws + WS_HY); bf16_t* P = (bf16_t*)(ws + WS_P);
  float* xmeta = (float*)(ws + WS_XMETA);

#ifndef PH_MASK
#define PH_MASK 0xFFFF
#endif
  if (TIDX < 2) ((LAS unsigned*)(ldsl + LDS_BYTES - 64))[TIDX] = 0u;
  __syncthreads();
  if (PH_MASK & 1) phase_prologue(p, ldsl, wave_s);
  grid.sync();
  const XcdBarrier bar = xcd_barrier_post((unsigned*)(ws + WS_BAR), (volatile LAS unsigned*)(ldsl + LDS_BYTES - 64), wave_s);
#define GSYNC() xcd_barrier(bar, wave_s)
#pragma unroll 1
  for (int layer = 0; layer < DEPTH; ++layer) {
    const float lambda_init = (layer == 0) ? 0.2f : (0.8f - 0.6f * 0.7408182206817179f);
    const float* res_meta = (layer == 0) ? p.meta : xmeta; const float* res_body = (layer == 0) ? p.x : p.out;
    if (PH_MASK & 2) phase_rmsnorm(res_meta, res_body, p.norm_w + layer * DM, HY, wave_s);
    GSYNC();
    if (PH_MASK & 4) { pg8::Gemm g{HY, (const bf16_t*)(ws + WS_WIN) + (size_t)layer * INP * DM, MP, INP, DM, DM}; pg8::StaticOrder S; S.init(MP, INP, G, (int)blockIdx.x);
      pg8::EpiBf16 E{P, INP};
      pg8::gemm_phase<pg8::EpiBf16, pg8::StaticOrder, true, true>(ldsl, g, S, E, wave_s); }
    GSYNC();
    if (PH_MASK & 8) phase_post1(p, layer, wave_s);
    GSYNC();
    if (PH_MASK & 16) { pg8::Gemm g{P + C_CQ, (const bf16_t*)(ws + WS_WUQ) + (size_t)layer * 768 * 384, MP, 768, 384, INP}; pg8::StaticOrder S; S.init(MP, 768, G, (int)blockIdx.x);
      pg8::EpiBf16 E{(bf16_t*)(ws + WS_QC), 768};
      pg8::gemm_phase<pg8::EpiBf16, pg8::StaticOrder, true, true>(ldsl, g, S, E, wave_s); }
    if (PH_MASK & 16) { pg8::Gemm g{P + C_CKV, (const bf16_t*)(ws + WS_WUKV) + (size_t)layer * 1024 * 256, SEQ, 1024, 256, INP}; pg8::StaticOrder S; S.init(SEQ, 1024, G, (int)((blockIdx.x + 195) % G));
      pg8::EpiBf16 E{(bf16_t*)(ws + WS_KVC), 1024};
      pg8::gemm_phase<pg8::EpiBf16, pg8::StaticOrder, true, true>(ldsl, g, S, E, wave_s);
      bf16_t* kvc = (bf16_t*)(ws + WS_KVC);
      small_gemm16(P + (size_t)SEQ * INP + C_CKV, INP, g.Bt, 1024, 256, [=](int r, int c, float v) { kvc[(size_t)(SEQ + r) * 1024 + c] = (bf16_t)f2bf(v); }, ldsl, wave_s); }
    if (PH_MASK & 16) { pg8::Gemm g{(const bf16_t*)(ws + WS_POOL), (const bf16_t*)(ws + WS_WD) + (size_t)layer * 512 * 512, MP, 512, 512, 512}; pg8::StaticOrder S; S.init(MP, 512, G, (int)((blockIdx.x + 199) % G));
      pg8::EpiBf16 E{P + C_DU, INP};
      pg8::gemm_phase<pg8::EpiBf16, pg8::StaticOrder, true, true>(ldsl, g, S, E, wave_s); }
    GSYNC();
    if (PH_MASK & 32) phase_post2(p, layer, wave_s);
    GSYNC();
    if (PH_MASK & 64) phase_attn(p, layer, (char*)lds, layer, wave_s);
#ifdef PROBE_DUP_ATT
    GSYNC(); if (layer == 0) phase_attn(p, layer, (char*)lds, 4, wave_s);
#endif
    GSYNC();
    if (PH_MASK & 128) phase_post3(p, layer, lambda_init, wave_s);
    GSYNC();
    if (PH_MASK & 256) { pg8::Gemm g{HY, (const bf16_t*)(ws + WS_WOUT) + (size_t)layer * DM * DM, SEQ, DM, DM, DM}; pg8::StaticOrder S; S.init(SEQ, DM, G, (int)blockIdx.x);
      pg8::EpiRes E{res_meta, res_body, (layer == 0) ? xmeta : nullptr, p.out, DM, NMETA, LROWS, (layer == DEPTH - 1) ? 1 : 0};
      pg8::gemm_phase<pg8::EpiRes, pg8::StaticOrder, true, true>(ldsl, g, S, E, wave_s);
      { const float* rb = res_body; float* ob = p.out;
        small_gemm16(HY + (size_t)SEQ * DM, DM, g.Bt, DM, DM, [=](int r, int c, float v) { const size_t i = (size_t)(SEQ - NMETA + r) * DM + c; ob[i] = rb[i] + v; }, ldsl, wave_s); } }
    if (layer + 1 < DEPTH) GSYNC();
  }
}

extern "C" void kernel_launch(void* const* d_in, const int* in_sizes, int n_in, void* d_out, int out_size, void* d_ws, size_t ws_size, hipStream_t stream) {
  static int grid = 0;
  if (grid == 0) {
    if (n_in != 19 || in_sizes[0] != SEQ * DM || out_size != SEQ * DM || ws_size < WS_END) {
      fprintf(stderr, "kernel_launch: unexpected shapes: n_in %d in0 %d out %d ws %zu (need %zu)\n", n_in, n_in > 0 ? in_sizes[0] : -1, out_size, ws_size, (size_t)WS_END); grid = -1; return; }
    int dev = 0, cus = 0, per_cu = 0;
    hipGetDevice(&dev); hipDeviceGetAttribute(&cus, hipDeviceAttributeMultiprocessorCount, dev);
    if (hipFuncSetAttribute((const void*)hybrid_fwd, hipFuncAttributeMaxDynamicSharedMemorySize, LDS_BYTES) != hipSuccess) { fprintf(stderr, "kernel_launch: hipFuncSetAttribute failed\n"); grid = -1; return; }
    if (hipOccupancyMaxActiveBlocksPerMultiprocessor(&per_cu, (const void*)hybrid_fwd, 512, LDS_BYTES) != hipSuccess || per_cu < 1) { fprintf(stderr, "kernel_launch: occupancy query says %d\n", per_cu); per_cu = 1; }
    (void)hipGetLastError();
    grid = cus * 1;
  }
  if (grid < 0) return;
  Params p{};
  const float** fp = (const float**)&p;
  for (int i = 0; i < 19; ++i) fp[i] = (const float*)d_in[i];
  p.out = (float*)d_out; p.ws = (unsigned char*)d_ws;
  for (int j = 0; j < 8; ++j) p.inv_a[j] = (float)pow(500000.0, -(double)(2 * j) / 16.0);
  for (int j = 0; j < 32; ++j) { p.inv_b[j] = (float)pow(10000.0, -(double)(2 * j) / 64.0); p.inv_c[j] = (float)pow(500000.0, -(double)(2 * j) / 64.0); }
  void* args[] = {&p};
  hipError_t e = hipLaunchCooperativeKernel((const void*)hybrid_fwd, dim3(grid), dim3(512), args, LDS_BYTES, stream);
  if (e != hipSuccess) fprintf(stderr, "kernel_launch: cooperative launch failed: %s (grid %d)\n", hipGetErrorString(e), grid);
}
```

```cpp
#include <hip/hip_runtime.h>
#include <hip/hip_cooperative_groups.h>
#include <hip/hip_bf16.h>
#include <cstdio>
#include <cstdint>
#include <cmath>
namespace cg = cooperative_groups;
__device__ __forceinline__ int lane_id_v() { int l; asm volatile("v_mbcnt_lo_u32_b32 %0, -1, 0\n\tv_mbcnt_hi_u32_b32 %0, -1, %0" : "=v"(l)); return l; }
#define TIDX ((int)((wave_s << 6) | lane_id_v()))

namespace pg8 {
#define PG8_LAS __attribute__((address_space(3)))
typedef unsigned short bf16_t;
typedef short bf16x8 __attribute__((ext_vector_type(8)));
typedef float f32x4 __attribute__((ext_vector_type(4)));
typedef unsigned u32x4 __attribute__((ext_vector_type(4)));
constexpr int BM = 256, BK = 64, HALF = 128, HTB = HALF * BK * 2  , STAGE_BYTES = 8 * HTB, NXCD = 8, WGM = 8;

__host__ __device__ __forceinline__ int lds_byte(int r, int c) { const int st = (r >> 4) * 2 + (c >> 5), rr = r & 15, cc = c & 31, ob = rr * 64 + cc * 2; return st * 1024 + (ob ^ (((ob >> 9) & 1) << 5)); }
__host__ __device__ __forceinline__ void stage_rc(int b, int& R, int& C) { const int st = b / 1024, sb = b % 1024, swz = sb ^ (((sb >> 9) & 1) << 5); R = (st >> 1) * 16 + swz / 64; C = (st & 1) * 32 + (swz % 64) / 2; }
__host__ __device__ __forceinline__ int perm32(int rho) { const int n = rho >> 4, i = rho & 15; return 8 * (i >> 2) + 4 * n + (i & 3); }

struct Unit { int pm, pn; };
struct Gemm { const bf16_t* A; const bf16_t* Bt; int M, N, K, lda; };

struct StaticOrder {
    int nM, nN, nwg, G, c;
    __host__ __device__ void init(int M, int N, int G_, int c_) { nM = M / BM; nN = N / BM; nwg = nM * nN; G = G_; c = c_; }
    __host__ __device__ bool next(int i, Unit& u) const {
        const long L = (long)i * G + c; if (L >= nwg) return false;
        int wgid = (int)L; { const int q = nwg / NXCD, r = nwg % NXCD, xcd = wgid % NXCD, off = wgid / NXCD; wgid = (xcd < r ? xcd * (q + 1) : r * (q + 1) + (xcd - r) * q) + off; }
        const int nig = WGM * nN, gid = wgid / nig, fm = gid * WGM, gsz = (nM - fm) < WGM ? (nM - fm) : WGM;
        u.pm = fm + ((wgid % nig) % gsz); u.pn = (wgid % nig) / gsz; return true;
    }
    __device__ __forceinline__ void a_ready(const Unit&) const {}
    __device__ __forceinline__ void done(const Unit&) const {}
};

__device__ __forceinline__ unsigned cvt_pk_bf16(float lo, float hi) { unsigned r; asm volatile("v_cvt_pk_bf16_f32 %0, %1, %2" : "=v"(r) : "v"(lo), "v"(hi)); return r; }

struct EpiBf16 {
    static constexpr bool PERM = true, AFTER_DRAIN = false;
    bf16_t* O; int ldc;
    __device__ __forceinline__ void operator()(const f32x4 (&acc)[2][2][4][2], const Unit& u, int wr, int wc, int fr, int fq) const {
        const int row0 = u.pm * BM + wr * 64 + fr; const int col0 = u.pn * BM + wc * 32 + 8 * fq;
#pragma unroll
        for (int ai = 0; ai < 2; ++ai)
#pragma unroll
            for (int m = 0; m < 4; ++m) { bf16_t* rowp = O + (size_t)(row0 + ai * HALF + m * 16) * ldc + col0;
#pragma unroll
                for (int bj = 0; bj < 2; ++bj) { const f32x4 v0 = acc[ai][bj][m][0], v1 = acc[ai][bj][m][1];
                    u32x4 w; w.x = cvt_pk_bf16(v0[0], v0[1]); w.y = cvt_pk_bf16(v0[2], v0[3]); w.z = cvt_pk_bf16(v1[0], v1[1]); w.w = cvt_pk_bf16(v1[2], v1[3]);
                    *(u32x4*)(rowp + bj * HALF) = w; } }
    }
};
struct EpiRes {
    static constexpr bool PERM = false, AFTER_DRAIN = false;
    const float* res_meta; const float* res_body; float* out_meta; float* out_body; int ldc, nmeta, lrows;
    __device__ __forceinline__ void operator()(const f32x4 (&acc)[2][2][4][2], const Unit& u, int wr, int wc, int fr, int fq) const {
        const int row0 = u.pm * BM + wr * 64 + fr; const int col0 = u.pn * BM + wc * 32 + 4 * fq;
#pragma unroll
        for (int ai = 0; ai < 2; ++ai)
#pragma unroll
            for (int m = 0; m < 4; ++m) { const int r = row0 + ai * HALF + m * 16;
                if (r < lrows) {
                    const float* rp = (r < nmeta) ? res_meta + (size_t)r * ldc : res_body + (size_t)(r - nmeta) * ldc;
                    float* op = (r < nmeta) ? out_meta : out_body;
                    if (op) { op += (r < nmeta) ? (size_t)r * ldc : (size_t)(r - nmeta) * ldc;
#pragma unroll
                    for (int bj = 0; bj < 2; ++bj)
#pragma unroll
                        for (int n = 0; n < 2; ++n) { const int c = col0 + bj * HALF + n * 16; const f32x4 b = *(const f32x4*)(rp + c); *(f32x4*)(op + c) = b + acc[ai][bj][m][n]; } } } }
    }
};

template <class Epi, class Sched, bool ALIGN_EPI = false, bool SP2 = false>
__device__ __forceinline__ void gemm_phase(PG8_LAS unsigned char* lds, const Gemm g, const Sched& S, const Epi& E, const int wave_s) {
    int tid_ = TIDX; asm volatile("" : "+v"(tid_));
    const int tid = tid_, wid = __builtin_amdgcn_readfirstlane(tid >> 6), lane = tid & 63, wr = wid >> 2, wc = wid & 3, fr = lane & 15, fq = lane >> 4;
    const int K = g.K, nt = K / BK;
    unsigned voffA[2], voffB[2];
#pragma unroll
    for (int i = 0; i < 2; ++i) { int R, C; stage_rc(tid * 16 + i * 8192, R, C); const int Rb = Epi::PERM ? ((R & ~31) + perm32(R & 31)) : R;
        voffA[i] = (unsigned)(R * g.lda + C) * 2u; voffB[i] = (unsigned)(Rb * K + C) * 2u; }
    const size_t kstep = (size_t)(BK * 2);
    const size_t hstep = (size_t)HALF * K * 2;
    const size_t tstep = 2 * hstep; const size_t hstepA = (size_t)HALF * g.lda * 2, tstepA = 2 * hstepA;
    const unsigned ldsw = (unsigned)wid * 1024u;
    const int aoff = lds_byte(wr * 64 + fr, fq * 8), boff = lds_byte(wc * 32 + fr, fq * 8);
#define PG8_SA(b, h) (((b) * 2 + (h)) * HTB)
#define PG8_SB(b, h) ((4 + (b) * 2 + (h)) * HTB)
#define PG8_STAGE(bufoff, gbase, voff) do { _Pragma("unroll") for (int _i = 0; _i < 2; ++_i) \
        __builtin_amdgcn_global_load_lds((const unsigned*)((const char*)(gbase) + (voff)[_i]), (PG8_LAS unsigned*)(lds + (bufoff) + ldsw + _i * 8192), 16, 0, 0); } while (0)
#define PG8_LDA(dst, b, h) do { _Pragma("unroll") for (int m = 0; m < 4; ++m) _Pragma("unroll") for (int k = 0; k < 2; ++k) dst[m][k] = *(const PG8_LAS bf16x8*)(lds + PG8_SA(b, h) + aoff + m * 2048 + k * 1024); } while (0)
#define PG8_LDB(dst, b, h) do { _Pragma("unroll") for (int n = 0; n < 2; ++n) _Pragma("unroll") for (int k = 0; k < 2; ++k) dst[n][k] = *(const PG8_LAS bf16x8*)(lds + PG8_SB(b, h) + boff + n * 2048 + k * 1024); } while (0)
#define PG8_MMA(ai, bj, At, Bt) do { __builtin_amdgcn_s_setprio(1); _Pragma("unroll") for (int m = 0; m < 4; ++m) _Pragma("unroll") for (int n = 0; n < 2; ++n) _Pragma("unroll") for (int k = 0; k < 2; ++k) \
        acc[ai][bj][m][n] = __builtin_amdgcn_mfma_f32_16x16x32_bf16(Bt[n][k], At[m][k], acc[ai][bj][m][n], 0, 0, 0); __builtin_amdgcn_s_setprio(0); } while (0)
#define PG8_WAIT_V(n) asm volatile("s_waitcnt vmcnt(" #n ")" ::: "memory")
#define PG8_WAIT_L(n) asm volatile("s_waitcnt lgkmcnt(" #n ")" ::: "memory")
#define PG8_BAR __builtin_amdgcn_s_barrier()
#define PG8_SCHED __builtin_amdgcn_sched_barrier(0)
    Unit cur, nxt; int ui = 0;
    if (!S.next(0, cur)) return;
    f32x4 acc[2][2][4][2];
#pragma unroll
    for (int a = 0; a < 2; ++a)
#pragma unroll
        for (int b = 0; b < 2; ++b)
#pragma unroll
            for (int m = 0; m < 4; ++m)
#pragma unroll
                for (int n = 0; n < 2; ++n) acc[a][b][m][n] = (f32x4){0.f, 0.f, 0.f, 0.f};
    bf16x8 At[4][2], B0[2][2], B1[2][2];
    const char* cA = (const char*)g.A + (size_t)cur.pm * tstepA; const char* cB = (const char*)g.Bt + (size_t)cur.pn * tstep;
    S.a_ready(cur);
    if constexpr (SP2) {
        PG8_STAGE(PG8_SB(0, 0), cB, voffB); PG8_STAGE(PG8_SB(0, 1), cB + hstep, voffB); PG8_STAGE(PG8_SA(0, 0), cA, voffA); PG8_STAGE(PG8_SA(0, 1), cA + hstepA, voffA);
        if (wr == 1) PG8_BAR;
        PG8_WAIT_V(2); PG8_BAR;
        PG8_STAGE(PG8_SB(1, 0), cB + kstep, voffB); PG8_STAGE(PG8_SA(1, 0), cA + kstep, voffA); PG8_STAGE(PG8_SB(1, 1), cB + hstep + kstep, voffB);
        PG8_WAIT_V(6); PG8_BAR;
    } else {
        PG8_STAGE(PG8_SB(0, 0), cB, voffB); PG8_STAGE(PG8_SA(0, 0), cA, voffA); PG8_STAGE(PG8_SB(0, 1), cB + hstep, voffB); PG8_STAGE(PG8_SA(0, 1), cA + hstepA, voffA);
        if (wr == 1) PG8_BAR;
        PG8_WAIT_V(4); PG8_BAR;
        PG8_STAGE(PG8_SB(1, 0), cB + kstep, voffB); PG8_STAGE(PG8_SA(1, 0), cA + kstep, voffA); PG8_STAGE(PG8_SB(1, 1), cB + hstep + kstep, voffB);
        PG8_WAIT_V(6); PG8_BAR;
    }
    for (;;) {
        const bool has_next = S.next(ui + 1, nxt);
        const char* nA = has_next ? (const char*)g.A + (size_t)nxt.pm * tstepA : cA; const char* nB = has_next ? (const char*)g.Bt + (size_t)nxt.pn * tstep : cB;
        for (int t = 0; t < nt; t += 2) {
            const bool last = (t == nt - 2);
            const char* a1 = cA + (size_t)(t + 1) * kstep;
            const char* a2 = last ? nA : cA + (size_t)(t + 2) * kstep; const char* b2 = last ? nB : cB + (size_t)(t + 2) * kstep;
            const char* a3 = a2 + kstep; const char* b3 = b2 + kstep;
            if (last && has_next) S.a_ready(nxt);
            if constexpr (SP2) {
            PG8_LDB(B0, 0, 0); PG8_LDB(B1, 0, 1); PG8_SCHED; PG8_LDA(At, 0, 0); PG8_STAGE(PG8_SA(1, 1), a1 + hstepA, voffA);
            PG8_WAIT_V(8); PG8_WAIT_L(0); PG8_BAR; PG8_MMA(0, 0, At, B0); PG8_MMA(0, 1, At, B1); PG8_BAR; PG8_SCHED;
            PG8_LDA(At, 0, 1); PG8_STAGE(PG8_SB(0, 0), b2, voffB); PG8_STAGE(PG8_SB(0, 1), b2 + hstep, voffB); PG8_STAGE(PG8_SA(0, 0), a2, voffA);
            PG8_WAIT_V(8); PG8_WAIT_L(0); PG8_BAR; PG8_MMA(1, 0, At, B0); PG8_MMA(1, 1, At, B1); PG8_BAR; PG8_SCHED;
            PG8_LDB(B0, 1, 0); PG8_LDB(B1, 1, 1); PG8_SCHED; PG8_LDA(At, 1, 0); PG8_STAGE(PG8_SA(0, 1), a2 + hstepA, voffA);
            PG8_WAIT_V(8); PG8_WAIT_L(0); PG8_BAR; PG8_MMA(0, 0, At, B0); PG8_MMA(0, 1, At, B1); PG8_BAR; PG8_SCHED;
            PG8_LDA(At, 1, 1); PG8_STAGE(PG8_SB(1, 0), b3, voffB); PG8_STAGE(PG8_SB(1, 1), b3 + hstep, voffB); PG8_STAGE(PG8_SA(1, 0), a3, voffA);
            PG8_WAIT_V(8); PG8_WAIT_L(0); PG8_BAR; PG8_MMA(1, 0, At, B0); PG8_MMA(1, 1, At, B1); PG8_BAR; PG8_SCHED;
            } else {
            PG8_LDB(B0, 0, 0); PG8_SCHED; PG8_LDA(At, 0, 0); PG8_STAGE(PG8_SA(1, 1), a1 + hstepA, voffA);
            PG8_WAIT_L(8); PG8_BAR; PG8_WAIT_L(0); PG8_MMA(0, 0, At, B0); PG8_BAR; PG8_SCHED;
            PG8_LDB(B1, 0, 1); PG8_STAGE(PG8_SB(0, 0), b2, voffB);
            PG8_BAR; PG8_WAIT_L(0); PG8_MMA(0, 1, At, B1); PG8_BAR;
            PG8_LDA(At, 0, 1); PG8_STAGE(PG8_SA(0, 0), a2, voffA);
            PG8_BAR; PG8_WAIT_L(0); PG8_MMA(1, 0, At, B0); PG8_BAR; PG8_SCHED;
            PG8_STAGE(PG8_SB(0, 1), b2 + hstep, voffB);
            PG8_WAIT_V(6); PG8_BAR; PG8_MMA(1, 1, At, B1); PG8_BAR;
            PG8_LDB(B0, 1, 0); PG8_SCHED; PG8_LDA(At, 1, 0); PG8_STAGE(PG8_SA(0, 1), a2 + hstepA, voffA);
            PG8_WAIT_L(8); PG8_BAR; PG8_WAIT_L(0); PG8_MMA(0, 0, At, B0); PG8_BAR; PG8_SCHED;
            PG8_LDB(B1, 1, 1); PG8_STAGE(PG8_SB(1, 0), b3, voffB);
            PG8_BAR; PG8_WAIT_L(0); PG8_MMA(0, 1, At, B1); PG8_BAR;
            PG8_LDA(At, 1, 1); PG8_STAGE(PG8_SA(1, 0), a3, voffA);
            PG8_BAR; PG8_WAIT_L(0); PG8_MMA(1, 0, At, B0); PG8_BAR; PG8_SCHED;
            PG8_STAGE(PG8_SB(1, 1), b3 + hstep, voffB);
            PG8_WAIT_V(6); PG8_BAR; PG8_MMA(1, 1, At, B1); PG8_BAR;
            }
        }
        if constexpr (ALIGN_EPI) { if (wr == 0) PG8_BAR; }
        if constexpr (!Epi::AFTER_DRAIN) { E(acc, cur, wr, wc, fr, fq); S.done(cur); }
        if (!has_next) break;
#pragma unroll
        for (int a = 0; a < 2; ++a)
#pragma unroll
            for (int b = 0; b < 2; ++b)
#pragma unroll
                for (int m = 0; m < 4; ++m)
#pragma unroll
                    for (int n = 0; n < 2; ++n) acc[a][b][m][n] = (f32x4){0.f, 0.f, 0.f, 0.f};
        cur = nxt; cA = nA; cB = nB; ++ui;
        if constexpr (ALIGN_EPI) { if (wr == 1) PG8_BAR; }
    }
    PG8_WAIT_V(0);
    if constexpr (!ALIGN_EPI) { if (wr == 0) PG8_BAR; }
    PG8_BAR;
    if constexpr (Epi::AFTER_DRAIN) { E.fused(acc, cur, wr, wc, fr, fq, lds, wid, lane); S.done(cur); }
#undef PG8_SA
#undef PG8_SB
#undef PG8_STAGE
#undef PG8_LDA
#undef PG8_LDB
#undef PG8_MMA
#undef PG8_WAIT_V
#undef PG8_WAIT_L
#undef PG8_BAR
#undef PG8_SCHED
}
}

#ifndef ATT_KPRELOAD
#define ATT_KPRELOAD 1
#endif
#ifndef ATT_KEARLY
#define ATT_KEARLY 1
#endif
#ifndef ATT_STAGE_LATE
#define ATT_STAGE_LATE 4
#endif
#ifndef ATT_STEP_VPIPE
#define ATT_STEP_VPIPE 1
#endif
#ifndef ATT_STEP
#define ATT_STEP 0
#endif
namespace att {
using bf16 = unsigned short;
using bf16x8 = __attribute__((ext_vector_type(8))) short;
using s16x4  = __attribute__((ext_vector_type(4))) short;
using f32x16 = __attribute__((ext_vector_type(16))) float;
using u32x4  = __attribute__((ext_vector_type(4))) unsigned;
constexpr int NW = 8, QBLK = 32, KVBLK = 64;
constexpr int LROWS = 16400;
constexpr int NT = 257;
constexpr float THR = 8.f;
constexpr int SHM_V = KVBLK * 128 * 2;
constexpr int K_OFF = 4 * SHM_V, WS_OFF = K_OFF + 4 * KVBLK * 128 * 2, ATT_LDS = WS_OFF + NW * 64 * 4;
static_assert(2 * KVBLK * 192 * 2 <= 4 * KVBLK * 128 * 2, "K region");
#define SBAR() __builtin_amdgcn_sched_barrier(0)
__device__ __forceinline__ int crow(int r, int hi) { return (r & 3) + 8 * (r >> 2) + 4 * hi; }
__device__ __forceinline__ unsigned cvtpk(float lo, float hi) { unsigned r; asm volatile("v_cvt_pk_bf16_f32 %0, %1, %2" : "=v"(r) : "v"(lo), "v"(hi)); return r; }
__device__ __forceinline__ bf16x8 ld8(const bf16* p) { return *reinterpret_cast<const bf16x8*>(p); }

template <bool FIXM>
__device__ __forceinline__ void partialSM(f32x16& p0, f32x16& p1, float& m_reg, float& mn, float& alpha, const float C, const float thrS, const int kb, const int hi) {
  if constexpr (FIXM) {
#pragma unroll
    for (int r = 0; r < 16; ++r) p0[r] = __builtin_amdgcn_exp2f(p0[r]);
    if (kb + KVBLK > LROWS) {
#pragma unroll
      for (int r = 0; r < 16; ++r) { if (kb + crow(r, hi) >= LROWS) p0[r] = 0.f; }
    }
    return;
  }
  if (kb + KVBLK > LROWS) {
#pragma unroll
    for (int r = 0; r < 16; ++r) { const int k0 = kb + crow(r, hi); if (k0 >= LROWS) p0[r] = -1e30f; if (k0 + 32 >= LROWS) p1[r] = -1e30f; }
  }
  float pmax = p0[0];
#pragma unroll
  for (int r = 1; r < 16; ++r) pmax = fmaxf(pmax, p0[r]);
#pragma unroll
  for (int r = 0; r < 16; ++r) pmax = fmaxf(pmax, p1[r]);
  { auto rr = __builtin_amdgcn_permlane32_swap(__float_as_uint(pmax), __float_as_uint(pmax), false, false);
    pmax = fmaxf(__uint_as_float(rr[0]), __uint_as_float(rr[1])); }
  if (__builtin_expect(__all(pmax - m_reg <= thrS), 1)) { mn = m_reg; alpha = 1.f; }
  else { mn = fmaxf(m_reg, pmax); alpha = __builtin_amdgcn_exp2f((m_reg - mn) * C); m_reg = mn; }
  const float mnC = -mn * C;
#pragma unroll
  for (int r = 0; r < 16; ++r) p0[r] = fmaf(p0[r], C, mnC);
#pragma unroll
  for (int r = 0; r < 16; ++r) p1[r] = fmaf(p1[r], C, mnC);
#pragma unroll
  for (int r = 0; r < 16; ++r) p0[r] = __builtin_amdgcn_exp2f(p0[r]);
}
template <bool FIXM>
__device__ __forceinline__ void finishSM(f32x16& p0, f32x16& p1, float alpha, float& l_reg, bf16x8& pa0, bf16x8& pa1, bf16x8& pa2, bf16x8& pa3, const int kb, const int hi) {
#pragma unroll
  for (int r = 0; r < 16; ++r) p1[r] = __builtin_amdgcn_exp2f(p1[r]);
  if constexpr (FIXM) { if (kb + KVBLK > LROWS) {
#pragma unroll
    for (int r = 0; r < 16; ++r) { if (kb + 32 + crow(r, hi) >= LROWS) p1[r] = 0.f; } } }
  float ps = 0;
#pragma unroll
  for (int r = 0; r < 16; ++r) ps += p0[r];
#pragma unroll
  for (int r = 0; r < 16; ++r) ps += p1[r];
  if constexpr (FIXM) l_reg += ps; else l_reg = l_reg * alpha + ps;
#define PK4(P, BASE, OUT) do { unsigned a0 = cvtpk(P[BASE + 0], P[BASE + 1]), a1 = cvtpk(P[BASE + 2], P[BASE + 3]);   \
    unsigned b0 = cvtpk(P[BASE + 4], P[BASE + 5]), b1 = cvtpk(P[BASE + 6], P[BASE + 7]);                              \
    u32x4 w = {a0, a1, b0, b1}; OUT = *reinterpret_cast<bf16x8*>(&w); } while (0)
  PK4(p0, 0, pa0); PK4(p0, 8, pa1); PK4(p1, 0, pa2); PK4(p1, 8, pa3);
#undef PK4
}
#define KSWZ(KP, row, colB) ((row) * (KP) + ((colB) ^ ((KP) == 256 ? (((row) & 15) << 4) : ((((row) >> 1) & 7) << 4))))
template <int DQK>
__device__ __forceinline__ void qkt(f32x16& p0, f32x16& p1, const char* Ks, const bf16x8* qr, int r32, int hi) {
  constexpr int KP = DQK * 2;
  p0 = f32x16{}; p1 = f32x16{};
  if constexpr (DQK == 64 && ATT_KPRELOAD) {
    bf16x8 ka[4], kq[4];
#pragma unroll
    for (int d0 = 0; d0 < 4; ++d0) { const int cb = (d0 * 16 + hi * 8) * 2;
      ka[d0] = *reinterpret_cast<const bf16x8*>(Ks + KSWZ(KP, r32, cb)); kq[d0] = *reinterpret_cast<const bf16x8*>(Ks + KSWZ(KP, 32 + r32, cb)); }
    SBAR();
#pragma unroll
    for (int d0 = 0; d0 < 4; ++d0) { p0 = __builtin_amdgcn_mfma_f32_32x32x16_bf16(ka[d0], qr[d0], p0, 0, 0, 0); p1 = __builtin_amdgcn_mfma_f32_32x32x16_bf16(kq[d0], qr[d0], p1, 0, 0, 0); }
    return;
  }
#pragma unroll
  for (int d0 = 0; d0 < DQK / 16; ++d0) { const int cb = (d0 * 16 + hi * 8) * 2;
    bf16x8 b0 = *reinterpret_cast<const bf16x8*>(Ks + KSWZ(KP, r32, cb));
    bf16x8 b1 = *reinterpret_cast<const bf16x8*>(Ks + KSWZ(KP, 32 + r32, cb));
    p0 = __builtin_amdgcn_mfma_f32_32x32x16_bf16(b0, qr[d0], p0, 0, 0, 0);
    p1 = __builtin_amdgcn_mfma_f32_32x32x16_bf16(b1, qr[d0], p1, 0, 0, 0); }
}
__device__ __forceinline__ int v_st(int k, int c) { const int kk = k; return ((kk >> 3) * 4 + (c >> 5)) * 512 + ((kk & 7) * 32 + (c & 31)) * 2; }
__device__ __forceinline__ int v_rd_base(int lane) { return ((lane & 3) << 3) | (((lane >> 2) & 3) << 6) | (((lane >> 4) & 1) << 5) | (((lane >> 5) & 1) << 8); }
constexpr int v_rd_off(int d0, int ks, int half) { return d0 * 512 + ks * 4096 + half * 2048; }
template <int OFF> __device__ __forceinline__ s16x4 tr_read(int vb) {
  s16x4 r; asm volatile("ds_read_b64_tr_b16 %0, %1 offset:%2" : "=&v"(r) : "v"(vb), "i"(OFF) : "memory"); return r;
}
template <int D0> __device__ __forceinline__ void pv_one(f32x16& od, int vb, bf16x8 pa0, bf16x8 pa1, bf16x8 pa2, bf16x8 pa3) {
  const s16x4 l0 = tr_read<v_rd_off(D0, 0, 0)>(vb), h0 = tr_read<v_rd_off(D0, 0, 1)>(vb), l1 = tr_read<v_rd_off(D0, 1, 0)>(vb), h1 = tr_read<v_rd_off(D0, 1, 1)>(vb);
  const s16x4 l2 = tr_read<v_rd_off(D0, 2, 0)>(vb), h2 = tr_read<v_rd_off(D0, 2, 1)>(vb), l3 = tr_read<v_rd_off(D0, 3, 0)>(vb), h3 = tr_read<v_rd_off(D0, 3, 1)>(vb);
  asm volatile("s_waitcnt lgkmcnt(0)" ::: "memory"); SBAR();
#define PK(L, H) (bf16x8){L[0], L[1], L[2], L[3], H[0], H[1], H[2], H[3]}
  od = __builtin_amdgcn_mfma_f32_32x32x16_bf16(pa0, PK(l0, h0), od, 0, 0, 0);
  od = __builtin_amdgcn_mfma_f32_32x32x16_bf16(pa1, PK(l1, h1), od, 0, 0, 0);
  od = __builtin_amdgcn_mfma_f32_32x32x16_bf16(pa2, PK(l2, h2), od, 0, 0, 0);
  od = __builtin_amdgcn_mfma_f32_32x32x16_bf16(pa3, PK(l3, h3), od, 0, 0, 0);
#undef PK
}
__device__ __forceinline__ void pv_d0(f32x16* o, int vb, bf16x8 pa0, bf16x8 pa1, bf16x8 pa2, bf16x8 pa3) {
  pv_one<0>(o[0], vb, pa0, pa1, pa2, pa3); pv_one<1>(o[1], vb, pa0, pa1, pa2, pa3); pv_one<2>(o[2], vb, pa0, pa1, pa2, pa3); pv_one<3>(o[3], vb, pa0, pa1, pa2, pa3);
}
__device__ __forceinline__ float bf2f(unsigned short b) { return __uint_as_float((unsigned)b << 16); }
__device__ __forceinline__ unsigned f2bf(float f) { unsigned u = __float_as_uint(f); return (u + 0x7fffu + ((u >> 16) & 1u)) >> 16; }
struct VF { s16x4 l0, h0, l1, h1, l2, h2, l3, h3; };
template <int D0> __device__ __forceinline__ void v_issue(VF& f, int vb) {
  f.l0 = tr_read<v_rd_off(D0, 0, 0)>(vb); f.h0 = tr_read<v_rd_off(D0, 0, 1)>(vb); f.l1 = tr_read<v_rd_off(D0, 1, 0)>(vb); f.h1 = tr_read<v_rd_off(D0, 1, 1)>(vb);
  f.l2 = tr_read<v_rd_off(D0, 2, 0)>(vb); f.h2 = tr_read<v_rd_off(D0, 2, 1)>(vb); f.l3 = tr_read<v_rd_off(D0, 3, 0)>(vb); f.h3 = tr_read<v_rd_off(D0, 3, 1)>(vb);
}
__device__ __forceinline__ void pv_mma(f32x16& od, const VF& f, bf16x8 pa0, bf16x8 pa1, bf16x8 pa2, bf16x8 pa3) {
#define PK(L, H) (bf16x8){L[0], L[1], L[2], L[3], H[0], H[1], H[2], H[3]}
  od = __builtin_amdgcn_mfma_f32_32x32x16_bf16(pa0, PK(f.l0, f.h0), od, 0, 0, 0);
  od = __builtin_amdgcn_mfma_f32_32x32x16_bf16(pa1, PK(f.l1, f.h1), od, 0, 0, 0);
  od = __builtin_amdgcn_mfma_f32_32x32x16_bf16(pa2, PK(f.l2, f.h2), od, 0, 0, 0);
  od = __builtin_amdgcn_mfma_f32_32x32x16_bf16(pa3, PK(f.l3, f.h3), od, 0, 0, 0);
#undef PK
}
__device__ __forceinline__ void pv_pipe(f32x16* o, int vb, VF& f0, VF& f1, bf16x8 pa0, bf16x8 pa1, bf16x8 pa2, bf16x8 pa3) {
  v_issue<1>(f1, vb); asm volatile("s_waitcnt lgkmcnt(8)" ::: "memory"); SBAR(); pv_mma(o[0], f0, pa0, pa1, pa2, pa3); SBAR();
  v_issue<2>(f0, vb); asm volatile("s_waitcnt lgkmcnt(8)" ::: "memory"); SBAR(); pv_mma(o[1], f1, pa0, pa1, pa2, pa3); SBAR();
  v_issue<3>(f1, vb); asm volatile("s_waitcnt lgkmcnt(8)" ::: "memory"); SBAR(); pv_mma(o[2], f0, pa0, pa1, pa2, pa3); SBAR();
  asm volatile("s_waitcnt lgkmcnt(0)" ::: "memory"); SBAR(); pv_mma(o[3], f1, pa0, pa1, pa2, pa3);
}

template <int DQK, int SDEPTH, int MODE, int PIPE, int ldq, int ldk, int ldv, int ldo, int ldy, int ldg, bool SPLIT = false, bool FIXM = false, bool KVT2 = false>
__device__ __forceinline__ void attn_unit(const int wave_s, const bf16* __restrict__ Qb, const bf16* __restrict__ Kh, const bf16* __restrict__ Vh,
                                          const float scale, const int nvalid, float* __restrict__ Of, bf16* __restrict__ Yb,
                                          const bf16* __restrict__ Gb, char* lds, const int kb0_ = 0, const int nt_ = NT, float* __restrict__ part = nullptr) {
  const int kb0 = SPLIT ? kb0_ : 0, nt = SPLIT ? nt_ : NT;
  Kh += (long)kb0 * ldk; Vh += (long)kb0 * ldv;
  constexpr int ND0 = DQK / 16, KP = DQK * 2, SHM_K = KVBLK * KP, KPT = DQK / 64, NKP = DQK / 8;
  int tid_ = TIDX; asm volatile("" : "+v"(tid_));
  const int tid = tid_, wid = tid >> 6, lane = tid & 63, r32 = lane & 31, hi = lane >> 5;
  char* V_lds = lds; char* K_lds = lds + K_OFF;
  float* ws = (float*)(lds + WS_OFF) + wid * 64; float* li_l = ws; float* al_l = ws + 32;
  const float C = scale * 1.4426950408889634f, thrS = THR / scale;
  float m_reg = -1e30f, l_reg = 0; f32x16 o[4] = {}; bf16x8 qr[ND0];
  const bf16* Qw = Qb + (long)(wid * QBLK + r32) * ldq + hi * 8;
#pragma unroll
  for (int d0 = 0; d0 < ND0; ++d0) qr[d0] = ld8(Qw + d0 * 16);
  const int sr = tid >> 4, sc = (tid & 15) * 8, vst0 = v_st(sr, sc), vst1 = v_st(32 + sr, sc);
  const int vg0 = sr * ldv + sc, vg1 = (32 + sr) * ldv + sc;
  int kst[KPT], kg[KPT];
#pragma unroll
  for (int i = 0; i < KPT; ++i) { const int p = tid + 512 * i, row = p / NKP, cp = p % NKP; kst[i] = KSWZ(KP, row, cp * 16); kg[i] = row * ldk + cp * 8; }
  const int vb0 = (int)(uintptr_t)V_lds + v_rd_base(lane);
  struct { bf16x8 vs0, vs1, ks[KPT]; } sr_[SDEPTH];
  const __amdgpu_buffer_rsrc_t rsK = __builtin_amdgcn_make_buffer_rsrc((void*)Kh, 0, 0x7fffffff, 0x00020000);
  const __amdgpu_buffer_rsrc_t rsV = __builtin_amdgcn_make_buffer_rsrc((void*)Vh, 0, 0x7fffffff, 0x00020000);
#define BLD(rs, voff, soff) __builtin_bit_cast(bf16x8, __builtin_amdgcn_raw_buffer_load_b128((rs), (voff), (soff), 0))
#define SLOAD(i, k0) do { const int sv_ = (k0) * (ldv * 2), sk_ = (k0) * (ldk * 2); sr_[i].vs0 = BLD(rsV, vg0 * 2, sv_); sr_[i].vs1 = BLD(rsV, vg1 * 2, sv_); \
    _Pragma("unroll") for (int q_ = 0; q_ < KPT; ++q_) sr_[i].ks[q_] = BLD(rsK, kg[q_] * 2, sk_); } while (0)
#define SWRITE(b, i) do { *(bf16x8*)(V_lds + (b) * SHM_V + vst0) = sr_[i].vs0; *(bf16x8*)(V_lds + (b) * SHM_V + vst1) = sr_[i].vs1; \
    _Pragma("unroll") for (int q_ = 0; q_ < KPT; ++q_) *(bf16x8*)(K_lds + (b) * SHM_K + kst[q_]) = sr_[i].ks[q_]; } while (0)
#define SWAIT() do { if constexpr (SDEPTH == 2) { if constexpr (KPT == 1) asm volatile("s_waitcnt vmcnt(3)" ::: "memory"); else if constexpr (KPT == 2) asm volatile("s_waitcnt vmcnt(4)" ::: "memory"); else asm volatile("s_waitcnt vmcnt(5)" ::: "memory"); } \
    else asm volatile("s_waitcnt vmcnt(0)" ::: "memory"); } while (0)
#define RESC(a) do { if constexpr (!FIXM) if (__any((a) < 1.f)) { if (hi == 0) al_l[r32] = (a); asm volatile("s_waitcnt lgkmcnt(0)" ::: "memory"); \
    _Pragma("unroll") for (int d = 0; d < 4; ++d) _Pragma("unroll") for (int r = 0; r < 16; ++r) o[d][r] *= al_l[crow(r, hi)]; } } while (0)
  f32x16 pA0, pA1, pB0, pB1; float mnA, mnB, alA, alB; bf16x8 pa0, pa1, pa2, pa3;
  if constexpr (PIPE == 0 && KVT2) {
    static_assert(SDEPTH == 2 && DQK <= 128, "double tiles need two staging slots and fit LDS only for DQK <= 128");
    const int nd = nt >> 1;
    SLOAD(0, 0); SLOAD(1, KVBLK); asm volatile("s_waitcnt vmcnt(0)" ::: "memory"); SWRITE(0, 0); SWRITE(1, 1); SLOAD(0, 2 * KVBLK); SLOAD(1, 3 * KVBLK);
    for (int jj = 0; jj < nd; ++jj) {
      const int b = jj & 1;
      __syncthreads();
      if (jj + 1 < nd) { SWRITE(2 * (b ^ 1), 0); SWRITE(2 * (b ^ 1) + 1, 1); }
      if (jj + 2 < nd) { SLOAD(0, (2 * jj + 4) * KVBLK); SLOAD(1, (2 * jj + 5) * KVBLK); }
#pragma unroll
      for (int sub = 0; sub < 2; ++sub) {
        const int sb = 2 * b + sub, kb = kb0 + (2 * jj + sub) * KVBLK;
        SBAR(); qkt<DQK>(pA0, pA1, K_lds + sb * SHM_K, qr, r32, hi); SBAR();
        const int vb = vb0 + sb * SHM_V;
        VF f0, f1; v_issue<0>(f0, vb);
        partialSM<FIXM>(pA0, pA1, m_reg, mnA, alA, C, thrS, kb, hi);
        RESC(alA);
        finishSM<FIXM>(pA0, pA1, alA, l_reg, pa0, pa1, pa2, pa3, kb, hi); SBAR();
        pv_pipe(o, vb, f0, f1, pa0, pa1, pa2, pa3);
      }
    }
  } else if constexpr (PIPE == 0 && !SPLIT && ATT_STEP) {
#define SLOADK(k0) do { const bf16* kp_ = Kh + (long)(k0) * ldk; _Pragma("unroll") for (int q_ = 0; q_ < KPT; ++q_) sr_[0].ks[q_] = ld8(kp_ + kg[q_]); } while (0)
#define SLOADV(k0) do { const bf16* vp_ = Vh + (long)(k0) * ldv; sr_[0].vs0 = ld8(vp_ + vg0); sr_[0].vs1 = ld8(vp_ + vg1); } while (0)
#define SWRITEK(b) do { _Pragma("unroll") for (int q_ = 0; q_ < KPT; ++q_) *(bf16x8*)(K_lds + (b) * SHM_K + kst[q_]) = sr_[0].ks[q_]; } while (0)
#define SWRITEV(b) do { *(bf16x8*)(V_lds + (b) * SHM_V + vst0) = sr_[0].vs0; *(bf16x8*)(V_lds + (b) * SHM_V + vst1) = sr_[0].vs1; } while (0)
    SLOADK(0); SLOADV(0); asm volatile("s_waitcnt vmcnt(0)" ::: "memory"); SWRITEK(0); SWRITEV(0); SLOADK(KVBLK); SLOADV(KVBLK);
    if (wave_s >= 4) __syncthreads();
    for (int j = 0; j < nt; ++j) {
      const int b = j & 1;
      __syncthreads();
      if (j + 1 < nt) { SWRITEK(b ^ 1); }
      if (j + 2 < nt) { SLOADK((j + 2) * KVBLK); }
      SBAR(); qkt<DQK>(pA0, pA1, K_lds + b * SHM_K, qr, r32, hi); SBAR();
      __syncthreads();
      if (j + 1 < nt) { SWRITEV(b ^ 1); }
      if (j + 2 < nt) { SLOADV((j + 2) * KVBLK); }
      { const int vb = vb0 + b * SHM_V, kb = kb0 + j * KVBLK;
        if constexpr (DQK != 192 && ATT_STEP_VPIPE) {
          VF f0, f1; v_issue<0>(f0, vb);
          partialSM<FIXM>(pA0, pA1, m_reg, mnA, alA, C, thrS, kb, hi); RESC(alA);
          finishSM<FIXM>(pA0, pA1, alA, l_reg, pa0, pa1, pa2, pa3, kb, hi); SBAR();
          pv_pipe(o, vb, f0, f1, pa0, pa1, pa2, pa3);
        } else {
          partialSM<FIXM>(pA0, pA1, m_reg, mnA, alA, C, thrS, kb, hi); RESC(alA);
          finishSM<FIXM>(pA0, pA1, alA, l_reg, pa0, pa1, pa2, pa3, kb, hi); SBAR();
          pv_d0(o, vb, pa0, pa1, pa2, pa3);
        } }
    }
    if (wave_s < 4) __syncthreads();
#undef SLOADK
#undef SLOADV
#undef SWRITEK
#undef SWRITEV
  } else if constexpr (PIPE == 0) {
    SLOAD(0, 0); asm volatile("s_waitcnt vmcnt(0)" ::: "memory"); SWRITE(0, 0); SLOAD(0, KVBLK);
    for (int j = 0; j < nt; ++j) {
      const int b = j & 1;
      __syncthreads();
      if constexpr (DQK == 64 && ATT_KEARLY) {
        bf16x8 ka[4], kq[4]; const char* Ks = K_lds + b * SHM_K;
#pragma unroll
        for (int d0 = 0; d0 < 4; ++d0) { const int cb = (d0 * 16 + hi * 8) * 2;
          ka[d0] = *reinterpret_cast<const bf16x8*>(Ks + KSWZ(KP, r32, cb)); kq[d0] = *reinterpret_cast<const bf16x8*>(Ks + KSWZ(KP, 32 + r32, cb)); }
        SBAR();
        if constexpr (!(ATT_STAGE_LATE & 1)) { if (j + 1 < nt) { SWRITE(b ^ 1, 0); } if (j + 2 < nt) { SLOAD(0, (j + 2) * KVBLK); } SBAR(); }
        pA0 = f32x16{}; pA1 = f32x16{};
#pragma unroll
        for (int d0 = 0; d0 < 4; ++d0) { pA0 = __builtin_amdgcn_mfma_f32_32x32x16_bf16(ka[d0], qr[d0], pA0, 0, 0, 0); pA1 = __builtin_amdgcn_mfma_f32_32x32x16_bf16(kq[d0], qr[d0], pA1, 0, 0, 0); }
        SBAR();
        if constexpr (ATT_STAGE_LATE & 1) { if (j + 1 < nt) { SWRITE(b ^ 1, 0); } if (j + 2 < nt) { SLOAD(0, (j + 2) * KVBLK); } SBAR(); }
      } else {
      constexpr bool LATE = (DQK == 128) ? ((ATT_STAGE_LATE & 2) != 0) : ((ATT_STAGE_LATE & 4) != 0);
      if constexpr (!LATE) { if (j + 1 < nt) { SWRITE(b ^ 1, 0); } if (j + 2 < nt) { SLOAD(0, (j + 2) * KVBLK); } }
      SBAR(); qkt<DQK>(pA0, pA1, K_lds + b * SHM_K, qr, r32, hi); SBAR();
      if constexpr (LATE) { if (j + 1 < nt) { SWRITE(b ^ 1, 0); } if (j + 2 < nt) { SLOAD(0, (j + 2) * KVBLK); } SBAR(); }
      }
      const int vb = vb0 + b * SHM_V;
      if constexpr (DQK != 192) {
        VF f0, f1; v_issue<0>(f0, vb);
        partialSM<FIXM>(pA0, pA1, m_reg, mnA, alA, C, thrS, kb0 + j * KVBLK, hi);
        RESC(alA);
        finishSM<FIXM>(pA0, pA1, alA, l_reg, pa0, pa1, pa2, pa3, kb0 + j * KVBLK, hi); SBAR();
        pv_pipe(o, vb, f0, f1, pa0, pa1, pa2, pa3);
      } else {
        partialSM<FIXM>(pA0, pA1, m_reg, mnA, alA, C, thrS, kb0 + j * KVBLK, hi);
        RESC(alA);
        finishSM<FIXM>(pA0, pA1, alA, l_reg, pa0, pa1, pa2, pa3, kb0 + j * KVBLK, hi); SBAR();
        pv_d0(o, vb, pa0, pa1, pa2, pa3);
      }
    }
  } else {
  constexpr int SE = 0, SO = SDEPTH - 1;
  SLOAD(SE, 0); asm volatile("s_waitcnt vmcnt(0)" ::: "memory"); SWRITE(0, SE); __syncthreads();
  qkt<DQK>(pA0, pA1, K_lds, qr, r32, hi); partialSM<FIXM>(pA0, pA1, m_reg, mnA, alA, C, thrS, kb0, hi);
  SLOAD(SO, KVBLK); if constexpr (SDEPTH == 2) { SLOAD(SE, 2 * KVBLK); }
  SWAIT(); SWRITE(1, SO); __syncthreads();
  for (int j = 1; j + 1 < nt; j += 2) {
    SBAR(); qkt<DQK>(pB0, pB1, K_lds + SHM_K, qr, r32, hi);
    finishSM<FIXM>(pA0, pA1, alA, l_reg, pa0, pa1, pa2, pa3, kb0 + (j - 1) * KVBLK, hi); SBAR();
    SLOAD(SO, (j + SDEPTH) * KVBLK); SBAR();
    pv_d0(o, vb0, pa0, pa1, pa2, pa3); partialSM<FIXM>(pB0, pB1, m_reg, mnB, alB, C, thrS, kb0 + j * KVBLK, hi);
    __syncthreads(); SWAIT(); SWRITE(0, SE);
    RESC(alB); __syncthreads();
    SBAR(); qkt<DQK>(pA0, pA1, K_lds, qr, r32, hi);
    finishSM<FIXM>(pB0, pB1, alB, l_reg, pa0, pa1, pa2, pa3, kb0 + j * KVBLK, hi); SBAR();
    if (SDEPTH == 1 || j + 3 < nt) SLOAD(SE, (j + 1 + SDEPTH) * KVBLK); SBAR();
    pv_d0(o, vb0 + SHM_V, pa0, pa1, pa2, pa3); partialSM<FIXM>(pA0, pA1, m_reg, mnA, alA, C, thrS, kb0 + (j + 1) * KVBLK, hi);
    __syncthreads(); SWAIT(); SWRITE(1, SO);
    RESC(alA); __syncthreads();
  }
  SBAR(); qkt<DQK>(pB0, pB1, K_lds + SHM_K, qr, r32, hi);
  finishSM<FIXM>(pA0, pA1, alA, l_reg, pa0, pa1, pa2, pa3, kb0 + (nt - 2) * KVBLK, hi); SBAR();
  pv_d0(o, vb0, pa0, pa1, pa2, pa3); partialSM<FIXM>(pB0, pB1, m_reg, mnB, alB, C, thrS, kb0 + (nt - 1) * KVBLK, hi);
  __syncthreads(); RESC(alB);
  finishSM<FIXM>(pB0, pB1, alB, l_reg, pa0, pa1, pa2, pa3, kb0 + (nt - 1) * KVBLK, hi); SBAR();
  pv_d0(o, vb0 + SHM_V, pa0, pa1, pa2, pa3);
  }
  { auto rr = __builtin_amdgcn_permlane32_swap(__float_as_uint(l_reg), __float_as_uint(l_reg), false, false);
    l_reg = __uint_as_float(rr[0]) + __uint_as_float(rr[1]); }
  if constexpr (SPLIT) if (part != nullptr) {
    if (wid == 0) {
#pragma unroll
      for (int r = 0; r < 16; ++r) { const int orow = crow(r, hi);
        if (orow < 16) {
#pragma unroll
          for (int d0 = 0; d0 < 4; ++d0) part[orow * 132 + d0 * 32 + r32] = o[d0][r]; } }
      if (hi == 0 && r32 < 16) { part[r32 * 132 + 128] = m_reg; part[r32 * 132 + 129] = l_reg; }
    }
    __syncthreads();
    return;
  }
  if (hi == 0) li_l[r32] = l_reg; asm volatile("s_waitcnt lgkmcnt(0)" ::: "memory");
#pragma unroll
  for (int r = 0; r < 16; ++r) { const int orow = wid * QBLK + crow(r, hi); const float rli = __builtin_amdgcn_rcpf(li_l[crow(r, hi)]);
    if (orow < nvalid) {
      if constexpr (MODE == 0) {
#pragma unroll
        for (int d0 = 0; d0 < 4; ++d0) Of[(long)orow * ldo + d0 * 32 + r32] = o[d0][r] * rli;
      } else {
#pragma unroll
        for (int d0 = 0; d0 < 4; ++d0) { const float g = bf2f(Gb[(long)orow * ldg + d0 * 32 + r32]); const float sg = g / (1.f + __expf(-g));
          Yb[(long)orow * ldy + d0 * 32 + r32] = (bf16)f2bf(o[d0][r] * rli * sg); }
      }
    } }
  __syncthreads();
#undef SLOAD
#undef SWRITE
#undef SWAIT
#undef RESC
}
}

#define LAS __attribute__((address_space(3)))
typedef unsigned short bf16_t;
typedef float f32x4 __attribute__((ext_vector_type(4)));
typedef unsigned u32x4 __attribute__((ext_vector_type(4)));
typedef unsigned u32x2 __attribute__((ext_vector_type(2)));
constexpr int DM = 2048, SEQ = 16384, NMETA = 16, LROWS = SEQ + NMETA, MP = 16640  , DEPTH = 2;
constexpr int INC = 5824, INP = 5888;
constexpr float EPS = 1e-6f;
constexpr int C_AQ = 0, C_AK = 512, C_AV = 1024, C_AG = 1536, C_BQ = 2048, C_BK = 2560, C_BV = 2816, C_BG = 3072,
              C_CQ = 3584, C_CKV = 3968, C_CKR = 4224, C_CG = 4288, C_DU = 4800, C_DG = 5312;
constexpr size_t MiB = 1u << 20;
constexpr size_t al256(size_t x) { return (x + 255) / 256 * 256; }
constexpr size_t WS_CTL = 0;
constexpr size_t WS_XMETA = 4096;
constexpr size_t WS_BAR = 256 * 1024;
constexpr size_t WS_PART = 512 * 1024;
constexpr size_t WS_WIN = 2 * MiB;
constexpr size_t WS_WOUT = WS_WIN + al256((size_t)DEPTH * INP * DM * 2);
constexpr size_t WS_WUQ = WS_WOUT + al256((size_t)DEPTH * DM * DM * 2);
constexpr size_t WS_WUKV = WS_WUQ + al256((size_t)DEPTH * 768 * 384 * 2);
constexpr size_t WS_WD = WS_WUKV + al256((size_t)DEPTH * 1024 * 256 * 2);
constexpr size_t WS_HY = WS_WD + al256((size_t)DEPTH * 512 * 512 * 2);
constexpr size_t WS_P = WS_HY + al256((size_t)MP * DM * 2);
constexpr size_t WS_POOL = WS_P + al256((size_t)MP * INP * 2);
constexpr size_t WS_QC = WS_POOL + al256((size_t)MP * 512 * 2);
constexpr size_t WS_KVC = WS_QC + al256((size_t)MP * 768 * 2);
constexpr size_t WS_KC = WS_KVC + al256((size_t)MP * 1024 * 2);
constexpr size_t WS_OA = WS_KC + al256((size_t)MP * 768 * 2);
constexpr size_t WS_END = WS_OA + al256((size_t)MP * 1024 * 4);

constexpr float LOG2E = 1.4426950408889634f, LN2 = 0.6931471805599453f;
constexpr float QS_A = 0.125f * LOG2E, QS_B = 0.08838834764831845f * LOG2E, QS_C = 0.07216878364870323f * LOG2E;
struct Params {
  const float *x, *meta, *norm_w, *w_in, *w_out, *a_q_norm, *a_k_norm, *a_lambda, *a_subln, *b_q_norm, *b_k_norm,
              *c_q_lat, *c_kv_lat, *c_w_uq, *c_w_ukv, *c_q_norm, *c_k_norm, *d_w_group, *d_scale;
  float* out; unsigned char* ws;
  float inv_a[8], inv_b[32], inv_c[32];
};

__device__ __forceinline__ float bf2f(unsigned short b) { return __uint_as_float((unsigned)b << 16); }
__device__ __forceinline__ float bflo(unsigned w) { return __uint_as_float(w << 16); }
__device__ __forceinline__ float bfhi(unsigned w) { return __uint_as_float(w & 0xffff0000u); }
__device__ __forceinline__ unsigned f2bf(float f) { unsigned u = __float_as_uint(f); return (u + 0x7fffu + ((u >> 16) & 1u)) >> 16; }
__device__ __forceinline__ unsigned pk2(float lo, float hi) { return f2bf(lo) | (f2bf(hi) << 16); }
__device__ __forceinline__ float silu(float g) { return g / (1.f + __expf(-g)); }
__device__ __forceinline__ float wave_sum(float v) {
#pragma unroll
  for (int o = 1; o < 64; o <<= 1) v += __shfl_xor(v, o);
  return v;
}
__device__ __forceinline__ float wave_max(float v) {
#pragma unroll
  for (int o = 1; o < 64; o <<= 1) v = fmaxf(v, __shfl_xor(v, o));
  return v;
}
__device__ __forceinline__ float sum16(float v) { v += __shfl_xor(v, 1); v += __shfl_xor(v, 2); v += __shfl_xor(v, 4); v += __shfl_xor(v, 8); return v; }
__device__ __forceinline__ void rope_cs(float pos, float inv, float& c, float& s) {
  const float ang = pos * inv;
  double rev = (double)ang * 0.15915494309189535; rev -= rint(rev);
  const float fr = (float)rev;
  s = __builtin_amdgcn_sinf(fr); c = __builtin_amdgcn_cosf(fr);
}
__device__ __forceinline__ void unpack8(const u32x4 w, float* x) { x[0] = bflo(w.x); x[1] = bfhi(w.x); x[2] = bflo(w.y); x[3] = bfhi(w.y); x[4] = bflo(w.z); x[5] = bfhi(w.z); x[6] = bflo(w.w); x[7] = bfhi(w.w); }
__device__ __forceinline__ u32x4 pack8(const float* x) { u32x4 w; w.x = pk2(x[0], x[1]); w.y = pk2(x[2], x[3]); w.z = pk2(x[4], x[5]); w.w = pk2(x[6], x[7]); return w; }

#define XB_TMO      128
#define XB_XCNT(j)  (256  + 64 * (j))
#define XB_XSUB(j)  (1280 + 64 * (j))
#define XB_XGEN(j)  (2304 + 64 * (j))
#define XB_TOP      3328
#define XB_TOPGEN   3392
#define XCD_BAR_WORDS 3456
#define XB_SPIN_CAP (1u << 18)

__device__ __forceinline__ unsigned xb_ld(unsigned* p)              { return __hip_atomic_load(p, __ATOMIC_RELAXED, __HIP_MEMORY_SCOPE_AGENT); }
__device__ __forceinline__ unsigned xb_add(unsigned* p, unsigned v) { return __hip_atomic_fetch_add(p, v, __ATOMIC_RELAXED, __HIP_MEMORY_SCOPE_AGENT); }
__device__ __forceinline__ unsigned xb_xcc_id() { return (unsigned)__builtin_amdgcn_s_getreg((3 << 11) | 20) & 0xFu; }
#define XB_SPIN(cond, bar) do { unsigned _sp = 0; while (cond) { __builtin_amdgcn_s_sleep(1); \
    if ((++_sp & 255u) == 0u) { if (xb_ld(&(bar)[XB_TMO])) break; if (_sp > XB_SPIN_CAP) { atomicAdd(&(bar)[XB_TMO], 1u); break; } } } } while (0)

struct XcdBarrier {
    unsigned* bar; unsigned x;
    volatile LAS unsigned* st;
};

__device__ __forceinline__ XcdBarrier xcd_barrier_post(unsigned* bar, volatile LAS unsigned* st, const int wave_s) {
    XcdBarrier b; b.bar = bar; b.x = xb_xcc_id(); b.st = st;
    if (TIDX == 0) (void)xb_add(&bar[XB_XCNT(b.x)], 1u);
    return b;
}
__device__ __forceinline__ void xcd_barrier_complete(unsigned* bar, unsigned x, unsigned& nloc, unsigned& nx) {
    const unsigned G = gridDim.x * gridDim.y * gridDim.z;
    unsigned sum, cnt, mine, sp = 0u;
    for (;;) {
        sum = 0u; cnt = 0u; mine = 0u;
#pragma unroll
        for (unsigned j = 0; j < 16; ++j) { const unsigned c = xb_ld(&bar[XB_XCNT(j)]); sum += c; cnt += (c > 0u) ? 1u : 0u; mine = (j == x) ? c : mine; }
        if (sum == G) break;
        __builtin_amdgcn_s_sleep(1);
        if ((++sp & 255u) == 0u) { if (xb_ld(&bar[XB_TMO])) break; if (sp > XB_SPIN_CAP) { atomicAdd(&bar[XB_TMO], 1u); break; } }
    }
    nloc = mine > 0u ? mine : 1u; nx = cnt > 0u ? cnt : 1u;
}

__device__ __forceinline__ void xcd_barrier(const XcdBarrier& b, const int wave_s) {
    asm volatile("s_waitcnt vmcnt(0)" ::: "memory");
    __syncthreads();
    if (TIDX == 0) {
        unsigned* bar = b.bar;
        __builtin_amdgcn_s_waitcnt(0);
        unsigned nloc = b.st[0], nx = b.st[1];
        if (nloc == 0u) { xcd_barrier_complete(bar, b.x, nloc, nx); b.st[0] = nloc; b.st[1] = nx; }
        const unsigned old = xb_add(&bar[XB_XSUB(b.x)], 1u);
        const unsigned gen = old / nloc;
        if (old + 1u == (gen + 1u) * nloc) {
            __builtin_amdgcn_fence(__ATOMIC_RELEASE, "agent");
            asm volatile("s_waitcnt vmcnt(0)" ::: "memory");
            const unsigned og = xb_add(&bar[XB_TOP], 1u);
            const unsigned tg = og / nx;
            if (og + 1u == (tg + 1u) * nx) xb_add(&bar[XB_TOPGEN], 1u);
            else XB_SPIN(xb_ld(&bar[XB_TOPGEN]) == tg, bar);
            __builtin_amdgcn_fence(__ATOMIC_ACQUIRE, "agent");
            xb_add(&bar[XB_XGEN(b.x)], 1u);
            asm volatile("s_waitcnt vmcnt(0)" ::: "memory");
        } else {
            XB_SPIN(xb_ld(&bar[XB_XGEN(b.x)]) == gen, bar);
            __builtin_amdgcn_fence(__ATOMIC_ACQUIRE, "agent");
            asm volatile("s_waitcnt vmcnt(0)" ::: "memory");
        }
    }
    __syncthreads();
}

__device__ __forceinline__ void tr_item(const float* __restrict__ W, int ldw, int sk0, int sn0, bf16_t* __restrict__ WT, int ldt, int dn0, int dk0, LAS float* scr, int lane, bool zero) {
  if (!zero) {
#pragma unroll 8
    for (int i = 0; i < 32; ++i) { const int kk = 2 * i + (lane >> 5); scr[kk * 33 + (lane & 31)] = W[(size_t)(sk0 + kk) * ldw + sn0 + (lane & 31)]; }
  }
  asm volatile("s_waitcnt lgkmcnt(0)" ::: "memory");
  const int c = lane & 7;
#pragma unroll
  for (int j = 0; j < 4; ++j) { const int n = (lane >> 3) + 8 * j; const LAS float* s = scr + (8 * c) * 33 + n;
    u32x4 o = {0u, 0u, 0u, 0u};
    if (!zero) { o.x = pk2(s[0 * 33], s[1 * 33]); o.y = pk2(s[2 * 33], s[3 * 33]); o.z = pk2(s[4 * 33], s[5 * 33]); o.w = pk2(s[6 * 33], s[7 * 33]); }
    *(u32x4*)(WT + (size_t)(dn0 + n) * ldt + dk0 + 8 * c) = o; }
  asm volatile("s_waitcnt lgkmcnt(0)" ::: "memory");
}

__device__ __forceinline__ void phase_prologue(const Params& p, LAS unsigned char* lds, const int wave_s) {
  int t_ = TIDX; asm volatile("" : "+v"(t_)); const int lane = t_ & 63, wave = __builtin_amdgcn_readfirstlane(t_ >> 6), gw = blockIdx.x * 8 + wave, NGW = gridDim.x * 8; (void)wave;
  LAS float* scr = (LAS float*)(lds + wave * 16384);
  unsigned char* ws = p.ws;
  constexpr int I_IN = (DM / 64) * (INC / 32), I_OUT = (DM / 64) * (DM / 32), I_UQ = (384 / 64) * (768 / 32), I_UKV = (256 / 64) * (1024 / 32), I_D = (512 / 64) * (512 / 32);
  constexpr int I_LAYER = I_IN + I_OUT + I_UQ + I_UKV + I_D;
  for (int it = gw; it < DEPTH * I_LAYER; it += NGW) {
    const int layer = it / I_LAYER; int r = it % I_LAYER;
    if (r < I_IN) { const int nblk = INC / 32, kb = r / nblk, nb = r % nblk;
      tr_item(p.w_in + (size_t)layer * DM * INC, INC, 64 * kb, 32 * nb, (bf16_t*)(ws + WS_WIN) + (size_t)layer * INP * DM, DM, 32 * nb, 64 * kb, scr, lane, false); continue; } r -= I_IN;
    if (r < I_OUT) { const int nblk = DM / 32, kb = r / nblk, nb = r % nblk;
      tr_item(p.w_out + (size_t)layer * DM * DM, DM, 64 * kb, 32 * nb, (bf16_t*)(ws + WS_WOUT) + (size_t)layer * DM * DM, DM, 32 * nb, 64 * kb, scr, lane, false); continue; } r -= I_OUT;
    if (r < I_UQ) { const int nblk = 768 / 32, kb = r / nblk, nb = r % nblk;
      tr_item(p.c_w_uq + (size_t)layer * 384 * 768, 768, 64 * kb, 32 * nb, (bf16_t*)(ws + WS_WUQ) + (size_t)layer * 768 * 384, 384, 32 * nb, 64 * kb, scr, lane, false); continue; } r -= I_UQ;
    if (r < I_UKV) { const int nblk = 1024 / 32, kb = r / nblk, nb = r % nblk;
      tr_item(p.c_w_ukv + (size_t)layer * 256 * 1024, 1024, 64 * kb, 32 * nb, (bf16_t*)(ws + WS_WUKV) + (size_t)layer * 1024 * 256, 256, 32 * nb, 64 * kb, scr, lane, false); continue; } r -= I_UKV;
    { const int nblk = 512 / 32, kb = r / nblk, nb = r % nblk, k0 = 64 * kb, n0 = 32 * nb, gk = k0 >> 7, gn = n0 >> 7;
      tr_item(p.d_w_group + ((size_t)layer * 4 + gk) * 128 * 128, 128, k0 & 127, n0 & 127, (bf16_t*)(ws + WS_WD) + (size_t)layer * 512 * 512, 512, n0, k0, scr, lane, gk != gn); }
  }
  for (int i = gw * 64 + lane; i < DEPTH * (INP - INC) * DM / 8; i += NGW * 64) { const int layer = i / ((INP - INC) * DM / 8), j = i % ((INP - INC) * DM / 8);
    *(u32x4*)((bf16_t*)(ws + WS_WIN) + (size_t)layer * INP * DM + (size_t)INC * DM + (size_t)j * 8) = (u32x4){0u, 0u, 0u, 0u}; }
  if (gw == 0) { ((unsigned*)(ws + WS_CTL))[lane] = 0u; ((unsigned*)(ws + WS_CTL))[64 + lane] = 0u; }
  if (gw < DEPTH) { const int layer = gw, ln = lane; int fastmask;
    const float* aqn = p.a_q_norm + layer * 64; const float* akn = p.a_k_norm + layer * 64; const float* bqn = p.b_q_norm + layer * 128; const float* bkn = p.b_k_norm + layer * 128;
    const float* cqn = p.c_q_norm + layer * 192; const float* ckn = p.c_k_norm + layer * 192;
    const float maq = wave_max(fabsf(aqn[ln])), mak = wave_max(fabsf(akn[ln]));
    const float mbq = wave_max(fmaxf(fabsf(bqn[ln]), fabsf(bqn[64 + ln]))), mbk = wave_max(fmaxf(fabsf(bkn[ln]), fabsf(bkn[64 + ln])));
    const float mcqn = wave_max(fmaxf(fabsf(cqn[ln]), fabsf(cqn[64 + ln]))), mcqr = wave_max(fabsf(cqn[128 + ln]));
    const float mckn = wave_max(fmaxf(fabsf(ckn[ln]), fabsf(ckn[64 + ln]))), mckr = wave_max(fabsf(ckn[128 + ln]));
    const float bA = 64.f * maq * mak * QS_A, bB = 128.f * mbq * mbk * QS_B;
    const float bC = sqrtf((128.f * mcqn * mcqn + 64.f * mcqr * mcqr) * (128.f * mckn * mckn + 64.f * mckr * mckr)) * QS_C;
    fastmask = (bC < 60.f ? 1 : 0) | (bB < 60.f ? 2 : 0) | (bA < 60.f ? 4 : 0);
    if (lane == 0) ((int*)(ws + WS_CTL))[256 + layer] = fastmask; }

  if (blockIdx.x == 0) { for (int i = t_; i < XCD_BAR_WORDS; i += 512) ((unsigned*)(ws + WS_BAR))[i] = 0u; }
}

__device__ __forceinline__ void phase_rmsnorm(const float* __restrict__ src_meta, const float* __restrict__ src_body, const float* __restrict__ w, bf16_t* __restrict__ H, const int wave_s) {
  int t_ = TIDX; asm volatile("" : "+v"(t_)); const int lane = t_ & 63, wave = __builtin_amdgcn_readfirstlane(t_ >> 6), gw = blockIdx.x * 8 + wave, NGW = gridDim.x * 8; (void)wave;
  for (int r = gw; r < MP; r += NGW) {
    u32x2* o8 = (u32x2*)(H + (size_t)r * DM) + lane;
    if (r >= LROWS) {
#pragma unroll
      for (int j = 0; j < 8; ++j) o8[64 * j] = (u32x2){0u, 0u};
      continue; }
    const float* row = (r < NMETA) ? src_meta + (size_t)r * DM : src_body + (size_t)(r - NMETA) * DM;
    const f32x4* xr = (const f32x4*)row + lane; f32x4 v[8]; float ss = 0.f;
#pragma unroll
    for (int j = 0; j < 8; ++j) { v[j] = xr[64 * j]; ss += (v[j].x * v[j].x + v[j].y * v[j].y) + (v[j].z * v[j].z + v[j].w * v[j].w); }
    const float rs = rsqrtf(wave_sum(ss) * (1.f / DM) + EPS);
#pragma unroll
    for (int j = 0; j < 8; ++j) { const f32x4 g = ((const f32x4*)w)[lane + 64 * j];
      o8[64 * j] = (u32x2){pk2(v[j].x * rs * g.x, v[j].y * rs * g.y), pk2(v[j].z * rs * g.z, v[j].w * rs * g.w)}; }
  }
}

__device__ __forceinline__ void phase_post1(const Params& p, int layer, const int wave_s) {
  int t_ = TIDX; asm volatile("" : "+v"(t_)); const int lane = t_ & 63, wave = __builtin_amdgcn_readfirstlane(t_ >> 6), gw = blockIdx.x * 8 + wave, NGW = gridDim.x * 8; (void)wave;
  bf16_t* P = (bf16_t*)(p.ws + WS_P); bf16_t* POOL = (bf16_t*)(p.ws + WS_POOL); bf16_t* KC = (bf16_t*)(p.ws + WS_KC);
  const float* aqn = p.a_q_norm + layer * 64; const float* akn = p.a_k_norm + layer * 64;
  const float* bqn = p.b_q_norm + layer * 128; const float* bkn = p.b_k_norm + layer * 128;
  const float* cql = p.c_q_lat + layer * 384; const float* ckvl = p.c_kv_lat + layer * 256; const float* ckn = p.c_k_norm + layer * 192;
  for (int r = gw; r < MP; r += NGW) {
    if (r >= LROWS) {
      *(u32x4*)(POOL + (size_t)r * 512 + lane * 8) = (u32x4){0u, 0u, 0u, 0u};
      for (int i = lane; i < 768 / 8; i += 64) *(u32x4*)(KC + (size_t)r * 768 + i * 8) = (u32x4){0u, 0u, 0u, 0u};
      continue; }
    bf16_t* pr = P + (size_t)r * INP;
    const float posf = (float)r;
    const float rowp = (r < NMETA) ? -1.f : (float)((r - NMETA) >> 6), colp = (r < NMETA) ? (float)r : (float)((r - NMETA) & 63);
    { float x[16]; u32x4* ptr = (u32x4*)(pr + C_AQ + lane * 16); const u32x4 w0 = ptr[0], w1 = ptr[1]; unpack8(w0, x); unpack8(w1, x + 8);
      float ss = 0.f;
#pragma unroll
      for (int i = 0; i < 16; ++i) ss += x[i] * x[i];
      ss += __shfl_xor(ss, 1); ss += __shfl_xor(ss, 2);
      const float rs = rsqrtf(ss * (1.f / 64.f) + EPS) * ((lane >> 5) ? 1.f : QS_A);
      const float* wn = ((lane >> 5) ? akn : aqn) + (lane & 3) * 16;
#pragma unroll
      for (int i = 0; i < 16; ++i) x[i] = x[i] * rs * wn[i];
      if ((lane & 3) == 0) {
#pragma unroll
        for (int j = 0; j < 8; ++j) { float c, s; rope_cs(posf, p.inv_a[j], c, s); const float x1 = x[j], x2 = x[8 + j]; x[j] = x1 * c - x2 * s; x[8 + j] = x1 * s + x2 * c; }
      }
      ptr[0] = pack8(x); ptr[1] = pack8(x + 8); }
#pragma unroll
    for (int pass = 0; pass < 2; ++pass) {
      const bool act = (pass == 0) || (lane < 32);
      u32x4* ptr = (u32x4*)(pr + (pass == 0 ? C_BQ : C_BK) + lane * 8);
      float x[8]; u32x4 w = {0u, 0u, 0u, 0u}; if (act) w = *ptr; unpack8(w, x);
      float ss = 0.f;
#pragma unroll
      for (int i = 0; i < 8; ++i) ss += x[i] * x[i];
      ss = sum16(ss);
      const float rs = rsqrtf(ss * (1.f / 128.f) + EPS) * (pass == 0 ? QS_B : 1.f);
      const int a = lane & 15; const float* wn = (pass == 0 ? bqn : bkn) + a * 8;
      const float posv = (a < 8) ? rowp : colp;
#pragma unroll
      for (int i = 0; i < 8; ++i) { const float y = x[i] * rs * wn[i]; const float other = __shfl_xor(y, 4);
        float c, s; rope_cs(posv, p.inv_b[(a & 3) * 8 + i], c, s);
        x[i] = (a & 4) ? other * s + y * c : y * c - other * s; }
      if (act) *ptr = pack8(x);
    }
    { unsigned* ptr = (unsigned*)(pr + C_CQ); unsigned w[3]; float ss = 0.f;
#pragma unroll
      for (int j = 0; j < 3; ++j) { w[j] = ptr[lane + 64 * j]; const float a = bflo(w[j]), b = bfhi(w[j]); ss += a * a + b * b; }
      const float rs = rsqrtf(wave_sum(ss) * (1.f / 384.f) + EPS);
#pragma unroll
      for (int j = 0; j < 3; ++j) { const int e = 2 * (lane + 64 * j); ptr[lane + 64 * j] = pk2(bflo(w[j]) * rs * cql[e], bfhi(w[j]) * rs * cql[e + 1]); } }
    { u32x2* ptr = (u32x2*)(pr + C_CKV) + lane; const u32x2 w = *ptr; const float a0 = bflo(w.x), a1 = bfhi(w.x), a2 = bflo(w.y), a3 = bfhi(w.y);
      const float rs = rsqrtf(wave_sum(a0 * a0 + a1 * a1 + a2 * a2 + a3 * a3) * (1.f / 256.f) + EPS);
      const float* g = ckvl + lane * 4;
      *ptr = (u32x2){pk2(a0 * rs * g[0], a1 * rs * g[1]), pk2(a2 * rs * g[2], a3 * rs * g[3])}; }
    { const float xk = bf2f(pr[C_CKR + lane]); const float rs = rsqrtf(wave_sum(xk * xk) * (1.f / 64.f) + EPS);
      const float y = xk * rs * ckn[128 + lane]; const float other = __shfl_xor(y, 32);
      float c, s; rope_cs(posf, p.inv_c[lane & 31], c, s);
      const float o = (lane & 32) ? other * s + y * c : y * c - other * s; const bf16_t ob = (bf16_t)f2bf(o);
#pragma unroll
      for (int h = 0; h < 4; ++h) KC[(size_t)r * 768 + h * 192 + 128 + lane] = ob; }
    { const int hw = 1 << (lane >> 4); const int lo = max(r - hw, 0), hi = min(r + hw, LROWS);
      float acc[8], u[8];
#pragma unroll
      for (int i = 0; i < 8; ++i) acc[i] = 0.f;
      u32x4 wv[16];
#pragma unroll
      for (int j = 0; j < 16; ++j) { const int t = min(max(r - 8 + j, 0), LROWS - 1); wv[j] = *(const u32x4*)(P + (size_t)t * INP + C_DU + lane * 8); }
#pragma unroll
      for (int j = 0; j < 16; ++j) { const int t = r - 8 + j; float x[8]; unpack8(wv[j], x); const bool in = (t >= lo) && (t < hi);
#pragma unroll
        for (int i = 0; i < 8; ++i) acc[i] += in ? x[i] : 0.f;
        if (j == 8) {
#pragma unroll
          for (int i = 0; i < 8; ++i) u[i] = x[i]; } }
      const float inv = 1.f / (float)(hi - lo);
#pragma unroll
      for (int i = 0; i < 8; ++i) acc[i] = acc[i] * inv - u[i];
      *(u32x4*)(POOL + (size_t)r * 512 + lane * 8) = pack8(acc); }
  }
}

__device__ __forceinline__ void phase_post2(const Params& p, int layer, const int wave_s) {
  int t_ = TIDX; asm volatile("" : "+v"(t_)); const int lane = t_ & 63, wave = __builtin_amdgcn_readfirstlane(t_ >> 6), gw = blockIdx.x * 8 + wave, NGW = gridDim.x * 8; (void)wave;
  bf16_t* QC = (bf16_t*)(p.ws + WS_QC); const bf16_t* KVC = (const bf16_t*)(p.ws + WS_KVC); bf16_t* KC = (bf16_t*)(p.ws + WS_KC);
  const float* cqn = p.c_q_norm + layer * 192; const float* ckn = p.c_k_norm + layer * 192;
  const int h = lane >> 4, a = lane & 15;
  for (int r = gw; r < LROWS; r += NGW) {
    const float posf = (float)r;
    { u32x4* ptr = (u32x4*)(QC + (size_t)r * 768 + h * 192 + a * 8); float x[8]; unpack8(*ptr, x); float ss = 0.f;
#pragma unroll
      for (int i = 0; i < 8; ++i) ss += x[i] * x[i];
      const float rs = rsqrtf(sum16(ss) * (1.f / 128.f) + EPS) * QS_C;
#pragma unroll
      for (int i = 0; i < 8; ++i) x[i] = x[i] * rs * cqn[a * 8 + i];
      *ptr = pack8(x); }
    { u32x2* ptr = (u32x2*)(QC + (size_t)r * 768 + h * 192 + 128 + a * 4); const u32x2 w = *ptr; float x[4] = {bflo(w.x), bfhi(w.x), bflo(w.y), bfhi(w.y)};
      const float rs = rsqrtf(sum16(x[0] * x[0] + x[1] * x[1] + x[2] * x[2] + x[3] * x[3]) * (1.f / 64.f) + EPS) * QS_C;
#pragma unroll
      for (int i = 0; i < 4; ++i) { const float y = x[i] * rs * cqn[128 + a * 4 + i]; const float other = __shfl_xor(y, 8);
        float c, s; rope_cs(posf, p.inv_c[(a & 7) * 4 + i], c, s);
        x[i] = (a & 8) ? other * s + y * c : y * c - other * s; }
      *ptr = (u32x2){pk2(x[0], x[1]), pk2(x[2], x[3])}; }
    { float x[8]; unpack8(*(const u32x4*)(KVC + (size_t)r * 1024 + h * 256 + a * 8), x); float ss = 0.f;
#pragma unroll
      for (int i = 0; i < 8; ++i) ss += x[i] * x[i];
      const float rs = rsqrtf(sum16(ss) * (1.f / 128.f) + EPS);
#pragma unroll
      for (int i = 0; i < 8; ++i) x[i] = x[i] * rs * ckn[a * 8 + i];
      *(u32x4*)(KC + (size_t)r * 768 + h * 192 + a * 8) = pack8(x); }
  }
}

__device__ __forceinline__ void meta_combine8(const float* __restrict__ ph, int r, int col0, float C, float* out) {
  float M = -1e30f;
#pragma unroll
  for (int sidx = 0; sidx < 8; ++sidx) M = fmaxf(M, ph[(sidx * 16 + r) * 132 + 128]);
  float l = 0.f, acc[8];
#pragma unroll
  for (int i = 0; i < 8; ++i) acc[i] = 0.f;
#pragma unroll
  for (int sidx = 0; sidx < 8; ++sidx) { const float* pp = ph + (sidx * 16 + r) * 132; const float w = exp2f((pp[128] - M) * C); l += pp[129] * w;
    const f32x4 a = *(const f32x4*)(pp + col0), b = *(const f32x4*)(pp + col0 + 4);
    acc[0] += a.x * w; acc[1] += a.y * w; acc[2] += a.z * w; acc[3] += a.w * w; acc[4] += b.x * w; acc[5] += b.y * w; acc[6] += b.z * w; acc[7] += b.w * w; }
  const float il = 1.f / l;
#pragma unroll
  for (int i = 0; i < 8; ++i) out[i] = acc[i] * il;
}

__device__ __forceinline__ void phase_post3(const Params& p, int layer, float lambda_init, const int wave_s) {
  int t_ = TIDX; asm volatile("" : "+v"(t_)); const int lane = t_ & 63, wave = __builtin_amdgcn_readfirstlane(t_ >> 6), gw = blockIdx.x * 8 + wave, NGW = gridDim.x * 8; (void)wave;
  const bf16_t* P = (const bf16_t*)(p.ws + WS_P); const float* OA = (const float*)(p.ws + WS_OA); bf16_t* Y = (bf16_t*)(p.ws + WS_HY);
  const float* lp = p.a_lambda + layer * 256; const float* sub = p.a_subln + layer * 128; const float* dsc = p.d_scale + layer * 512;
  const float lam = __expf(wave_sum(lp[lane] * lp[64 + lane])) - __expf(wave_sum(lp[128 + lane] * lp[192 + lane])) + lambda_init;
  const float post = 1.f - lambda_init;
  const int h = lane >> 4, a = lane & 15;
  const bool metasplit = (layer != DEPTH - 1);
  const float* PART = (const float*)(p.ws + WS_PART);
  for (int r = gw; r < LROWS; r += NGW) {
    if (metasplit && r < NMETA) {
      float x1[8], x2[8];
      meta_combine8(PART + (size_t)((8 + 2 * h) * 8 * 16) * 132, r, a * 8, 1.f, x1);
      meta_combine8(PART + (size_t)((8 + 2 * h + 1) * 8 * 16) * 132, r, a * 8, 1.f, x2);
      float x[8], ss = 0.f;
#pragma unroll
      for (int i = 0; i < 8; ++i) { x[i] = x1[i] - lam * x2[i]; ss += x[i] * x[i]; }
      const float rs = rsqrtf(sum16(ss) * (1.f / 128.f) + EPS);
      float g[8]; unpack8(*(const u32x4*)(P + (size_t)r * INP + C_AG + h * 128 + a * 8), g);
#pragma unroll
      for (int i = 0; i < 8; ++i) x[i] = x[i] * rs * sub[a * 8 + i] * post * silu(g[i]);
      *(u32x4*)(Y + (size_t)r * DM + h * 128 + a * 8) = pack8(x);
      meta_combine8(PART + (size_t)((4 + h) * 8 * 16) * 132, r, a * 8, 1.f, x1);
      unpack8(*(const u32x4*)(P + (size_t)r * INP + C_BG + h * 128 + a * 8), g);
#pragma unroll
      for (int i = 0; i < 8; ++i) x1[i] *= silu(g[i]);
      *(u32x4*)(Y + (size_t)r * DM + 512 + h * 128 + a * 8) = pack8(x1);
      meta_combine8(PART + (size_t)(h * 8 * 16) * 132, r, a * 8, 1.f, x2);
      unpack8(*(const u32x4*)(P + (size_t)r * INP + C_CG + h * 128 + a * 8), g);
#pragma unroll
      for (int i = 0; i < 8; ++i) x2[i] *= silu(g[i]);
      *(u32x4*)(Y + (size_t)r * DM + 1024 + h * 128 + a * 8) = pack8(x2);
    } else
    { const f32x4* o1 = (const f32x4*)(OA + (size_t)r * 1024 + (2 * h) * 128 + a * 8); const f32x4* o2 = (const f32x4*)(OA + (size_t)r * 1024 + (2 * h + 1) * 128 + a * 8);
      const f32x4 u0 = o1[0], u1 = o1[1], v0 = o2[0], v1 = o2[1];
      float x[8] = {u0.x - lam * v0.x, u0.y - lam * v0.y, u0.z - lam * v0.z, u0.w - lam * v0.w, u1.x - lam * v1.x, u1.y - lam * v1.y, u1.z - lam * v1.z, u1.w - lam * v1.w};
      float ss = 0.f;
#pragma unroll
      for (int i = 0; i < 8; ++i) ss += x[i] * x[i];
      const float rs = rsqrtf(sum16(ss) * (1.f / 128.f) + EPS);
      float g[8]; unpack8(*(const u32x4*)(P + (size_t)r * INP + C_AG + h * 128 + a * 8), g);
#pragma unroll
      for (int i = 0; i < 8; ++i) x[i] = x[i] * rs * sub[a * 8 + i] * post * silu(g[i]);
      *(u32x4*)(Y + (size_t)r * DM + h * 128 + a * 8) = pack8(x); }
    { float m[8], g[8]; unpack8(*(const u32x4*)(P + (size_t)r * INP + C_DU + lane * 8), m); unpack8(*(const u32x4*)(P + (size_t)r * INP + C_DG + lane * 8), g);
#pragma unroll
      for (int i = 0; i < 8; ++i) m[i] = m[i] * dsc[lane * 8 + i] * silu(g[i]);
      *(u32x4*)(Y + (size_t)r * DM + 1536 + lane * 8) = pack8(m); }
  }
}

#ifndef ATT_SD128
#define ATT_SD128 1
#endif
#ifndef ATT_KVT2_A
#define ATT_KVT2_A 0
#endif
#ifndef ATT_KVT2_B
#define ATT_KVT2_B 0
#endif
#ifndef ATT_STEP_VPIPE
#define ATT_STEP_VPIPE 1
#endif
#ifndef ATT_PIPE64
#define ATT_PIPE64 0
#endif
#ifndef ATT_PIPE128
#define ATT_PIPE128 0
#endif
#ifndef ATT_SD192
#define ATT_SD192 1
#endif
#ifndef ATT_PIPE192
#define ATT_PIPE192 0
#endif
__device__ __forceinline__ void phase_attn(const Params& p, int layer, char* lds, int slot, const int wave_s) {
  const bf16_t* P = (const bf16_t*)(p.ws + WS_P); const bf16_t* QC = (const bf16_t*)(p.ws + WS_QC); const bf16_t* KVC = (const bf16_t*)(p.ws + WS_KVC);
  const bf16_t* KC = (const bf16_t*)(p.ws + WS_KC); float* OA = (float*)(p.ws + WS_OA); bf16_t* Y = (bf16_t*)(p.ws + WS_HY);
  unsigned* ctr = (unsigned*)(p.ws + WS_CTL) + slot * 16;
  volatile int* sh = (volatile int*)(lds + att::ATT_LDS);
  const int fastmask = __builtin_amdgcn_readfirstlane(((const int*)(p.ws + WS_CTL))[256 + layer]);
  const int QLEN = (layer == DEPTH - 1) ? 128 : 144;
  float* PART = (float*)(p.ws + WS_PART);
  int q = (int)(__builtin_amdgcn_s_getreg((3 << 11) | 20) & 7u), tried = 0;
  for (;;) {
    __syncthreads();
    if (TIDX == 0) { int u = -1;
      while (tried < 8) { u = (int)__hip_atomic_fetch_add(ctr + q, 1u, __ATOMIC_RELAXED, __HIP_MEMORY_SCOPE_AGENT); if (u < QLEN) break; u = -1; q = (q + 1) & 7; ++tried; }
      sh[0] = u; sh[1] = q; }
    __syncthreads();
    const int u = __builtin_amdgcn_readfirstlane(sh[0]), qx = __builtin_amdgcn_readfirstlane(sh[1]);
    if (u < 0) break;
    int type, h, qb, sp = -1; float* part = nullptr;
    if (u < 128) { const int seg = u >> 5, i = u & 31; if (seg < 2) { type = seg; h = qx >> 1; qb = 32 * (qx & 1) + i; } else { type = 2; h = qx; qb = 32 * (seg - 2) + i; } }
    else { const int m = qx * 16 + (u - 128), hd = m >> 3; sp = m & 7; qb = 64; if (hd < 4) { type = 0; h = hd; } else if (hd < 8) { type = 1; h = hd - 4; } else { type = 2; h = hd - 8; }
      part = PART + (size_t)(m * 16) * 132; }
    const int q0 = qb < 64 ? NMETA + 256 * qb : 0, nv = qb < 64 ? 256 : NMETA;
    const int kb0 = sp < 0 ? 0 : sp * 2048, nt = sp < 0 ? att::NT : (sp == 7 ? att::NT - 7 * 32 : 32);
    if (part != nullptr || !((fastmask >> type) & 1)) {
      if (type == 0) att::attn_unit<192, 1, 1, 0, 768, 768, 1024, 0, DM, INP, true>(wave_s, QC + (size_t)q0 * 768 + h * 192, KC + h * 192, KVC + h * 256 + 128, LN2, nv,
                                nullptr, Y + (size_t)q0 * DM + 1024 + h * 128, P + (size_t)q0 * INP + C_CG + h * 128, lds, kb0, nt, part);
      else if (type == 1) att::attn_unit<128, 1, 1, 0, INP, INP, INP, 0, DM, INP, true>(wave_s, P + (size_t)q0 * INP + C_BQ + h * 128, P + C_BK + (h >> 1) * 128, P + C_BV + (h >> 1) * 128, LN2, nv,
                                nullptr, Y + (size_t)q0 * DM + 512 + h * 128, P + (size_t)q0 * INP + C_BG + h * 128, lds, kb0, nt, part);
      else att::attn_unit<64, 1, 0, 0, INP, INP, INP, 1024, 0, 0, true>(wave_s, P + (size_t)q0 * INP + C_AQ + h * 64, P + C_AK + h * 64, P + C_AV + (h >> 1) * 128, LN2, nv,
                               OA + (size_t)q0 * 1024 + h * 128, nullptr, nullptr, lds, kb0, nt, part);
    } else if (type == 0) {
      att::attn_unit<192, ATT_SD192, 1, ATT_PIPE192, 768, 768, 1024, 0, DM, INP, false, true>(wave_s, QC + (size_t)q0 * 768 + h * 192, KC + h * 192, KVC + h * 256 + 128, LN2, nv,
                                nullptr, Y + (size_t)q0 * DM + 1024 + h * 128, P + (size_t)q0 * INP + C_CG + h * 128, lds);
    } else if (type == 1) {
      att::attn_unit<128, 1 + ATT_KVT2_B, 1, ATT_PIPE128, INP, INP, INP, 0, DM, INP, false, true, ATT_KVT2_B != 0>(wave_s, P + (size_t)q0 * INP + C_BQ + h * 128, P + C_BK + (h >> 1) * 128, P + C_BV + (h >> 1) * 128, LN2, nv,
                                nullptr, Y + (size_t)q0 * DM + 512 + h * 128, P + (size_t)q0 * INP + C_BG + h * 128, lds);
    } else {
      att::attn_unit<64, 1 + ATT_KVT2_A, 0, ATT_PIPE64, INP, INP, INP, 1024, 0, 0, false, true, ATT_KVT2_A != 0>(wave_s, P + (size_t)q0 * INP + C_AQ + h * 64, P + C_AK + h * 64, P + C_AV + (h >> 1) * 128, LN2, nv,
                               OA + (size_t)q0 * 1024 + h * 128, nullptr, nullptr, lds);
    }
  }
}

typedef short bf16x8_t __attribute__((ext_vector_type(8)));
template <class F>
__device__ __forceinline__ void small_gemm16(const bf16_t* __restrict__ A, const int lda, const bf16_t* __restrict__ Bt, const int N, const int K, const F& store, LAS unsigned char* lds, const int wave_s) {
  int t_ = TIDX; asm volatile("" : "+v"(t_)); const int lane = t_ & 63; const int G = gridDim.x;
  LAS f32x4* red = (LAS f32x4*)lds;
  const int kpw = K >> 3, k0 = wave_s * kpw;
  for (int blk = (int)blockIdx.x; blk < N / 16; blk += G) {
    f32x4 acc = {0.f, 0.f, 0.f, 0.f};
    const bf16_t* ap = A + (size_t)(lane & 15) * lda + (lane >> 4) * 8 + k0;
    const bf16_t* bp = Bt + (size_t)(blk * 16 + (lane & 15)) * K + (lane >> 4) * 8 + k0;
#pragma unroll 8
    for (int k = 0; k < kpw; k += 32) acc = __builtin_amdgcn_mfma_f32_16x16x32_bf16(*(const bf16x8_t*)(ap + k), *(const bf16x8_t*)(bp + k), acc, 0, 0, 0);
    red[wave_s * 64 + lane] = acc;
    __syncthreads();
    if (wave_s == 0) {
      f32x4 t = red[lane];
#pragma unroll
      for (int w = 1; w < 8; ++w) t += red[w * 64 + lane];
#pragma unroll
      for (int j = 0; j < 4; ++j) store(4 * (lane >> 4) + j, blk * 16 + (lane & 15), t[j]);
    }
    __syncthreads();
  }
}

constexpr int LDS_BYTES = 147456;
__global__ void __launch_bounds__(512, 2) hybrid_fwd(Params p) {
  extern __shared__ __attribute__((aligned(16))) unsigned char lds[];
  cg::grid_group grid = cg::this_grid();
  const int G = gridDim.x;
  const int wave_s = __builtin_amdgcn_readfirstlane((int)__builtin_amdgcn_workitem_id_x() >> 6);
  LAS unsigned char* ldsl = (LAS unsigned char*)lds;
  unsigned char* ws = p.ws;
  bf16_t* HY = (bf16_t*)(ws + WS_HY); bf16_t* P = (bf16_t*)(ws + WS_P);
  float* xmeta = (float*)(ws + WS_XMETA);

#ifndef PH_MASK
#define PH_MASK 0xFFFF
#endif
  if (TIDX < 2) ((LAS unsigned*)(ldsl + LDS_BYTES - 64))[TIDX] = 0u;
  __syncthreads();
  if (PH_MASK & 1) phase_prologue(p, ldsl, wave_s);
  grid.sync();
  const XcdBarrier bar = xcd_barrier_post((unsigned*)(ws + WS_BAR), (volatile LAS unsigned*)(ldsl + LDS_BYTES - 64), wave_s);
#define GSYNC() xcd_barrier(bar, wave_s)
#pragma unroll 1
  for (int layer = 0; layer < DEPTH; ++layer) {
    const float lambda_init = (layer == 0) ? 0.2f : (0.8f - 0.6f * 0.7408182206817179f);
    const float* res_meta = (layer == 0) ? p.meta : xmeta; const float* res_body = (layer == 0) ? p.x : p.out;
    if (PH_MASK & 2) phase_rmsnorm(res_meta, res_body, p.norm_w + layer * DM, HY, wave_s);
    GSYNC();
    if (PH_MASK & 4) { pg8::Gemm g{HY, (const bf16_t*)(ws + WS_WIN) + (size_t)layer * INP * DM, MP, INP, DM, DM}; pg8::StaticOrder S; S.init(MP, INP, G, (int)blockIdx.x);
      pg8::EpiBf16 E{P, INP};
      pg8::gemm_phase<pg8::EpiBf16, pg8::StaticOrder, true, true>(ldsl, g, S, E, wave_s); }
    GSYNC();
    if (PH_MASK & 8) phase_post1(p, layer, wave_s);
    GSYNC();
    if (PH_MASK & 16) { pg8::Gemm g{P + C_CQ, (const bf16_t*)(ws + WS_WUQ) + (size_t)layer * 768 * 384, MP, 768, 384, INP}; pg8::StaticOrder S; S.init(MP, 768, G, (int)blockIdx.x);
      pg8::EpiBf16 E{(bf16_t*)(ws + WS_QC), 768};
      pg8::gemm_phase<pg8::EpiBf16, pg8::StaticOrder, true, true>(ldsl, g, S, E, wave_s); }
    if (PH_MASK & 16) { pg8::Gemm g{P + C_CKV, (const bf16_t*)(ws + WS_WUKV) + (size_t)layer * 1024 * 256, SEQ, 1024, 256, INP}; pg8::StaticOrder S; S.init(SEQ, 1024, G, (int)((blockIdx.x + 195) % G));
      pg8::EpiBf16 E{(bf16_t*)(ws + WS_KVC), 1024};
      pg8::gemm_phase<pg8::EpiBf16, pg8::StaticOrder, true, true>(ldsl, g, S, E, wave_s);
      bf16_t* kvc = (bf16_t*)(ws + WS_KVC);
      small_gemm16(P + (size_t)SEQ * INP + C_CKV, INP, g.Bt, 1024, 256, [=](int r, int c, float v) { kvc[(size_t)(SEQ + r) * 1024 + c] = (bf16_t)f2bf(v); }, ldsl, wave_s); }
    if (PH_MASK & 16) { pg8::Gemm g{(const bf16_t*)(ws + WS_POOL), (const bf16_t*)(ws + WS_WD) + (size_t)layer * 512 * 512, MP, 512, 512, 512}; pg8::StaticOrder S; S.init(MP, 512, G, (int)((blockIdx.x + 199) % G));
      pg8::EpiBf16 E{P + C_DU, INP};
      pg8::gemm_phase<pg8::EpiBf16, pg8::StaticOrder, true, true>(ldsl, g, S, E, wave_s); }
    GSYNC();
    if (PH_MASK & 32) phase_post2(p, layer, wave_s);
    GSYNC();
    if (PH_MASK & 64) phase_attn(p, layer, (char*)lds, layer, wave_s);
#ifdef PROBE_DUP_ATT
    GSYNC(); if (layer == 0) phase_attn(p, layer, (char*)lds, 4, wave_s);
#endif
    GSYNC();
    if (PH_MASK & 128) phase_post3(p, layer, lambda_init, wave_s);
    GSYNC();
    if (PH_MASK & 256) { pg8::Gemm g{HY, (const bf16_t*)(ws + WS_WOUT) + (size_t)layer * DM * DM, SEQ, DM, DM, DM}; pg8::StaticOrder S; S.init(SEQ, DM, G, (int)blockIdx.x);
      pg8::EpiRes E{res_meta, res_body, (layer == 0) ? xmeta : nullptr, p.out, DM, NMETA, LROWS};
      pg8::gemm_phase<pg8::EpiRes, pg8::StaticOrder, true, true>(ldsl, g, S, E, wave_s);
      { const float* rb = res_body; float* ob = p.out;
        small_gemm16(HY + (size_t)SEQ * DM, DM, g.Bt, DM, DM, [=](int r, int c, float v) { const size_t i = (size_t)(SEQ - NMETA + r) * DM + c; ob[i] = rb[i] + v; }, ldsl, wave_s); } }
    if (layer + 1 < DEPTH) GSYNC();
  }
}

extern "C" void kernel_launch(void* const* d_in, const int* in_sizes, int n_in, void* d_out, int out_size, void* d_ws, size_t ws_size, hipStream_t stream) {
  static int grid = 0;
  if (grid == 0) {
    if (n_in != 19 || in_sizes[0] != SEQ * DM || out_size != SEQ * DM || ws_size < WS_END) {
      fprintf(stderr, "kernel_launch: unexpected shapes: n_in %d in0 %d out %d ws %zu (need %zu)\n", n_in, n_in > 0 ? in_sizes[0] : -1, out_size, ws_size, (size_t)WS_END); grid = -1; return; }
    int dev = 0, cus = 0, per_cu = 0;
    hipGetDevice(&dev); hipDeviceGetAttribute(&cus, hipDeviceAttributeMultiprocessorCount, dev);
    if (hipFuncSetAttribute((const void*)hybrid_fwd, hipFuncAttributeMaxDynamicSharedMemorySize, LDS_BYTES) != hipSuccess) { fprintf(stderr, "kernel_launch: hipFuncSetAttribute failed\n"); grid = -1; return; }
    if (hipOccupancyMaxActiveBlocksPerMultiprocessor(&per_cu, (const void*)hybrid_fwd, 512, LDS_BYTES) != hipSuccess || per_cu < 1) { fprintf(stderr, "kernel_launch: occupancy query says %d\n", per_cu); per_cu = 1; }
    (void)hipGetLastError();
    grid = cus * 1;
  }
  if (grid < 0) return;
  Params p{};
  const float** fp = (const float**)&p;
  for (int i = 0; i < 19; ++i) fp[i] = (const float*)d_in[i];
  p.out = (float*)d_out; p.ws = (unsigned char*)d_ws;
  for (int j = 0; j < 8; ++j) p.inv_a[j] = (float)pow(500000.0, -(double)(2 * j) / 16.0);
  for (int j = 0; j < 32; ++j) { p.inv_b[j] = (float)pow(10000.0, -(double)(2 * j) / 64.0); p.inv_c[j] = (float)pow(500000.0, -(double)(2 * j) / 64.0); }
  void* args[] = {&p};
  hipError_t e = hipLaunchCooperativeKernel((const void*)hybrid_fwd, dim3(grid), dim3(512), args, LDS_BYTES, stream);
  if (e != hipSuccess) fprintf(stderr, "kernel_launch: cooperative launch failed: %s (grid %d)\n", hipGetErrorString(e), grid);
}
```

```cpp
#include <hip/hip_runtime.h>
#include <hip/hip_cooperative_groups.h>
#include <hip/hip_bf16.h>
#include <cstdio>
#include <cstdint>
#include <cmath>
namespace cg = cooperative_groups;
__device__ __forceinline__ int lane_id_v() { int l; asm volatile("v_mbcnt_lo_u32_b32 %0, -1, 0\n\tv_mbcnt_hi_u32_b32 %0, -1, %0" : "=v"(l)); return l; }
#define TIDX ((int)((wave_s << 6) | lane_id_v()))

namespace pg8 {
#define PG8_LAS __attribute__((address_space(3)))
typedef unsigned short bf16_t;
typedef short bf16x8 __attribute__((ext_vector_type(8)));
typedef float f32x4 __attribute__((ext_vector_type(4)));
typedef unsigned u32x4 __attribute__((ext_vector_type(4)));
constexpr int BM = 256, BK = 64, HALF = 128, HTB = HALF * BK * 2  , STAGE_BYTES = 8 * HTB, NXCD = 8, WGM = 8;

__host__ __device__ __forceinline__ int lds_byte(int r, int c) { const int st = (r >> 4) * 2 + (c >> 5), rr = r & 15, cc = c & 31, ob = rr * 64 + cc * 2; return st * 1024 + (ob ^ (((ob >> 9) & 1) << 5)); }
__host__ __device__ __forceinline__ void stage_rc(int b, int& R, int& C) { const int st = b / 1024, sb = b % 1024, swz = sb ^ (((sb >> 9) & 1) << 5); R = (st >> 1) * 16 + swz / 64; C = (st & 1) * 32 + (swz % 64) / 2; }
__host__ __device__ __forceinline__ int perm32(int rho) { const int n = rho >> 4, i = rho & 15; return 8 * (i >> 2) + 4 * n + (i & 3); }

struct Unit { int pm, pn; };
struct Gemm { const bf16_t* A; const bf16_t* Bt; int M, N, K, lda; };

struct StaticOrder {
    int nM, nN, nwg, G, c;
    __host__ __device__ void init(int M, int N, int G_, int c_) { nM = M / BM; nN = N / BM; nwg = nM * nN; G = G_; c = c_; }
    __host__ __device__ bool next(int i, Unit& u) const {
        const long L = (long)i * G + c; if (L >= nwg) return false;
        int wgid = (int)L; { const int q = nwg / NXCD, r = nwg % NXCD, xcd = wgid % NXCD, off = wgid / NXCD; wgid = (xcd < r ? xcd * (q + 1) : r * (q + 1) + (xcd - r) * q) + off; }
        const int nig = WGM * nN, gid = wgid / nig, fm = gid * WGM, gsz = (nM - fm) < WGM ? (nM - fm) : WGM;
        u.pm = fm + ((wgid % nig) % gsz); u.pn = (wgid % nig) / gsz; return true;
    }
    __device__ __forceinline__ void a_ready(const Unit&) const {}
    __device__ __forceinline__ void done(const Unit&) const {}
};

__device__ __forceinline__ unsigned cvt_pk_bf16(float lo, float hi) { unsigned r; asm volatile("v_cvt_pk_bf16_f32 %0, %1, %2" : "=v"(r) : "v"(lo), "v"(hi)); return r; }

struct EpiBf16 {
    static constexpr bool PERM = true, AFTER_DRAIN = false;
    bf16_t* O; int ldc;
    __device__ __forceinline__ void operator()(const f32x4 (&acc)[2][2][4][2], const Unit& u, int wr, int wc, int fr, int fq) const {
        const int row0 = u.pm * BM + wr * 64 + fr; const int col0 = u.pn * BM + wc * 32 + 8 * fq;
#pragma unroll
        for (int ai = 0; ai < 2; ++ai)
#pragma unroll
            for (int m = 0; m < 4; ++m) { bf16_t* rowp = O + (size_t)(row0 + ai * HALF + m * 16) * ldc + col0;
#pragma unroll
                for (int bj = 0; bj < 2; ++bj) { const f32x4 v0 = acc[ai][bj][m][0], v1 = acc[ai][bj][m][1];
                    u32x4 w; w.x = cvt_pk_bf16(v0[0], v0[1]); w.y = cvt_pk_bf16(v0[2], v0[3]); w.z = cvt_pk_bf16(v1[0], v1[1]); w.w = cvt_pk_bf16(v1[2], v1[3]);
                    *(u32x4*)(rowp + bj * HALF) = w; } }
    }
};
struct EpiRes {
    static constexpr bool PERM = false, AFTER_DRAIN = false;
    const float* res_meta; const float* res_body; float* out_meta; float* out_body; int ldc, nmeta, lrows;
    __device__ __forceinline__ void operator()(const f32x4 (&acc)[2][2][4][2], const Unit& u, int wr, int wc, int fr, int fq) const {
        const int row0 = u.pm * BM + wr * 64 + fr; const int col0 = u.pn * BM + wc * 32 + 4 * fq;
#pragma unroll
        for (int ai = 0; ai < 2; ++ai)
#pragma unroll
            for (int m = 0; m < 4; ++m) { const int r = row0 + ai * HALF + m * 16;
                if (r < lrows) {
                    const float* rp = (r < nmeta) ? res_meta + (size_t)r * ldc : res_body + (size_t)(r - nmeta) * ldc;
                    float* op = (r < nmeta) ? out_meta : out_body;
                    if (op) { op += (r < nmeta) ? (size_t)r * ldc : (size_t)(r - nmeta) * ldc;
#pragma unroll
                    for (int bj = 0; bj < 2; ++bj)
#pragma unroll
                        for (int n = 0; n < 2; ++n) { const int c = col0 + bj * HALF + n * 16; const f32x4 b = *(const f32x4*)(rp + c); *(f32x4*)(op + c) = b + acc[ai][bj][m][n]; } } } }
    }
};

template <class Epi, class Sched, bool ALIGN_EPI = false, bool SP2 = false>
__device__ __forceinline__ void gemm_phase(PG8_LAS unsigned char* lds, const Gemm g, const Sched& S, const Epi& E, const int wave_s) {
    int tid_ = TIDX; asm volatile("" : "+v"(tid_));
    const int tid = tid_, wid = __builtin_amdgcn_readfirstlane(tid >> 6), lane = tid & 63, wr = wid >> 2, wc = wid & 3, fr = lane & 15, fq = lane >> 4;
    const int K = g.K, nt = K / BK;
    unsigned voffA[2], voffB[2];
#pragma unroll
    for (int i = 0; i < 2; ++i) { int R, C; stage_rc(tid * 16 + i * 8192, R, C); const int Rb = Epi::PERM ? ((R & ~31) + perm32(R & 31)) : R;
        voffA[i] = (unsigned)(R * g.lda + C) * 2u; voffB[i] = (unsigned)(Rb * K + C) * 2u; }
    const size_t kstep = (size_t)(BK * 2);
    const size_t hstep = (size_t)HALF * K * 2;
    const size_t tstep = 2 * hstep; const size_t hstepA = (size_t)HALF * g.lda * 2, tstepA = 2 * hstepA;
    const unsigned ldsw = (unsigned)wid * 1024u;
    const int aoff = lds_byte(wr * 64 + fr, fq * 8), boff = lds_byte(wc * 32 + fr, fq * 8);
#define PG8_SA(b, h) (((b) * 2 + (h)) * HTB)
#define PG8_SB(b, h) ((4 + (b) * 2 + (h)) * HTB)
#define PG8_STAGE(bufoff, gbase, voff) do { _Pragma("unroll") for (int _i = 0; _i < 2; ++_i) \
        __builtin_amdgcn_global_load_lds((const unsigned*)((const char*)(gbase) + (voff)[_i]), (PG8_LAS unsigned*)(lds + (bufoff) + ldsw + _i * 8192), 16, 0, 0); } while (0)
#define PG8_LDA(dst, b, h) do { _Pragma("unroll") for (int m = 0; m < 4; ++m) _Pragma("unroll") for (int k = 0; k < 2; ++k) dst[m][k] = *(const PG8_LAS bf16x8*)(lds + PG8_SA(b, h) + aoff + m * 2048 + k * 1024); } while (0)
#define PG8_LDB(dst, b, h) do { _Pragma("unroll") for (int n = 0; n < 2; ++n) _Pragma("unroll") for (int k = 0; k < 2; ++k) dst[n][k] = *(const PG8_LAS bf16x8*)(lds + PG8_SB(b, h) + boff + n * 2048 + k * 1024); } while (0)
#define PG8_MMA(ai, bj, At, Bt) do { __builtin_amdgcn_s_setprio(1); _Pragma("unroll") for (int m = 0; m < 4; ++m) _Pragma("unroll") for (int n = 0; n < 2; ++n) _Pragma("unroll") for (int k = 0; k < 2; ++k) \
        acc[ai][bj][m][n] = __builtin_amdgcn_mfma_f32_16x16x32_bf16(Bt[n][k], At[m][k], acc[ai][bj][m][n], 0, 0, 0); __builtin_amdgcn_s_setprio(0); } while (0)
#define PG8_WAIT_V(n) asm volatile("s_waitcnt vmcnt(" #n ")" ::: "memory")
#define PG8_WAIT_L(n) asm volatile("s_waitcnt lgkmcnt(" #n ")" ::: "memory")
#define PG8_BAR __builtin_amdgcn_s_barrier()
#define PG8_SCHED __builtin_amdgcn_sched_barrier(0)
    Unit cur, nxt; int ui = 0;
    if (!S.next(0, cur)) return;
    f32x4 acc[2][2][4][2];
#pragma unroll
    for (int a = 0; a < 2; ++a)
#pragma unroll
        for (int b = 0; b < 2; ++b)
#pragma unroll
            for (int m = 0; m < 4; ++m)
#pragma unroll
                for (int n = 0; n < 2; ++n) acc[a][b][m][n] = (f32x4){0.f, 0.f, 0.f, 0.f};
    bf16x8 At[4][2], B0[2][2], B1[2][2];
    const char* cA = (const char*)g.A + (size_t)cur.pm * tstepA; const char* cB = (const char*)g.Bt + (size_t)cur.pn * tstep;
    S.a_ready(cur);
    if constexpr (SP2) {
        PG8_STAGE(PG8_SB(0, 0), cB, voffB); PG8_STAGE(PG8_SB(0, 1), cB + hstep, voffB); PG8_STAGE(PG8_SA(0, 0), cA, voffA); PG8_STAGE(PG8_SA(0, 1), cA + hstepA, voffA);
        if (wr == 1) PG8_BAR;
        PG8_WAIT_V(2); PG8_BAR;
        PG8_STAGE(PG8_SB(1, 0), cB + kstep, voffB); PG8_STAGE(PG8_SA(1, 0), cA + kstep, voffA); PG8_STAGE(PG8_SB(1, 1), cB + hstep + kstep, voffB);
        PG8_WAIT_V(6); PG8_BAR;
    } else {
        PG8_STAGE(PG8_SB(0, 0), cB, voffB); PG8_STAGE(PG8_SA(0, 0), cA, voffA); PG8_STAGE(PG8_SB(0, 1), cB + hstep, voffB); PG8_STAGE(PG8_SA(0, 1), cA + hstepA, voffA);
        if (wr == 1) PG8_BAR;
        PG8_WAIT_V(4); PG8_BAR;
        PG8_STAGE(PG8_SB(1, 0), cB + kstep, voffB); PG8_STAGE(PG8_SA(1, 0), cA + kstep, voffA); PG8_STAGE(PG8_SB(1, 1), cB + hstep + kstep, voffB);
        PG8_WAIT_V(6); PG8_BAR;
    }
    for (;;) {
        const bool has_next = S.next(ui + 1, nxt);
        const char* nA = has_next ? (const char*)g.A + (size_t)nxt.pm * tstepA : cA; const char* nB = has_next ? (const char*)g.Bt + (size_t)nxt.pn * tstep : cB;
        for (int t = 0; t < nt; t += 2) {
            const bool last = (t == nt - 2);
            const char* a1 = cA + (size_t)(t + 1) * kstep;
            const char* a2 = last ? nA : cA + (size_t)(t + 2) * kstep; const char* b2 = last ? nB : cB + (size_t)(t + 2) * kstep;
            const char* a3 = a2 + kstep; const char* b3 = b2 + kstep;
            if (last && has_next) S.a_ready(nxt);
            if constexpr (SP2) {
            PG8_LDB(B0, 0, 0); PG8_LDB(B1, 0, 1); PG8_SCHED; PG8_LDA(At, 0, 0); PG8_STAGE(PG8_SA(1, 1), a1 + hstepA, voffA);
            PG8_WAIT_V(8); PG8_WAIT_L(0); PG8_BAR; PG8_MMA(0, 0, At, B0); PG8_MMA(0, 1, At, B1); PG8_BAR; PG8_SCHED;
            PG8_LDA(At, 0, 1); PG8_STAGE(PG8_SB(0, 0), b2, voffB); PG8_STAGE(PG8_SB(0, 1), b2 + hstep, voffB); PG8_STAGE(PG8_SA(0, 0), a2, voffA);
            PG8_WAIT_V(8); PG8_WAIT_L(0); PG8_BAR; PG8_MMA(1, 0, At, B0); PG8_MMA(1, 1, At, B1); PG8_BAR; PG8_SCHED;
            PG8_LDB(B0, 1, 0); PG8_LDB(B1, 1, 1); PG8_SCHED; PG8_LDA(At, 1, 0); PG8_STAGE(PG8_SA(0, 1), a2 + hstepA, voffA);
            PG8_WAIT_V(8); PG8_WAIT_L(0); PG8_BAR; PG8_MMA(0, 0, At, B0); PG8_MMA(0, 1, At, B1); PG8_BAR; PG8_SCHED;
            PG8_LDA(At, 1, 1); PG8_STAGE(PG8_SB(1, 0), b3, voffB); PG8_STAGE(PG8_SB(1, 1), b3 + hstep, voffB); PG8_STAGE(PG8_SA(1, 0), a3, voffA);
            PG8_WAIT_V(8); PG8_WAIT_L(0); PG8_BAR; PG8_MMA(1, 0, At, B0); PG8_MMA(1, 1, At, B1); PG8_BAR; PG8_SCHED;
            } else {
            PG8_LDB(B0, 0, 0); PG8_SCHED; PG8_LDA(At, 0, 0); PG8_STAGE(PG8_SA(1, 1), a1 + hstepA, voffA);
            PG8_WAIT_L(8); PG8_BAR; PG8_WAIT_L(0); PG8_MMA(0, 0, At, B0); PG8_BAR; PG8_SCHED;
            PG8_LDB(B1, 0, 1); PG8_STAGE(PG8_SB(0, 0), b2, voffB);
            PG8_BAR; PG8_WAIT_L(0); PG8_MMA(0, 1, At, B1); PG8_BAR;
            PG8_LDA(At, 0, 1); PG8_STAGE(PG8_SA(0, 0), a2, voffA);
            PG8_BAR; PG8_WAIT_L(0); PG8_MMA(1, 0, At, B0); PG8_BAR; PG8_SCHED;
            PG8_STAGE(PG8_SB(0, 1), b2 + hstep, voffB);
            PG8_WAIT_V(6); PG8_BAR; PG8_MMA(1, 1, At, B1); PG8_BAR;
            PG8_LDB(B0, 1, 0); PG8_SCHED; PG8_LDA(At, 1, 0); PG8_STAGE(PG8_SA(0, 1), a2 + hstepA, voffA);
            PG8_WAIT_L(8); PG8_BAR; PG8_WAIT_L(0); PG8_MMA(0, 0, At, B0); PG8_BAR; PG8_SCHED;
            PG8_LDB(B1, 1, 1); PG8_STAGE(PG8_SB(1, 0), b3, voffB);
            PG8_BAR; PG8_WAIT_L(0); PG8_MMA(0, 1, At, B1); PG8_BAR;
            PG8_LDA(At, 1, 1); PG8_STAGE(PG8_SA(1, 0), a3, voffA);
            PG8_BAR; PG8_WAIT_L(0); PG8_MMA(1, 0, At, B0); PG8_BAR; PG8_SCHED;
            PG8_STAGE(PG8_SB(1, 1), b3 + hstep, voffB);
            PG8_WAIT_V(6); PG8_BAR; PG8_MMA(1, 1, At, B1); PG8_BAR;
            }
        }
        if constexpr (ALIGN_EPI) { if (wr == 0) PG8_BAR; }
        if constexpr (!Epi::AFTER_DRAIN) { E(acc, cur, wr, wc, fr, fq); S.done(cur); }
        if (!has_next) break;
#pragma unroll
        for (int a = 0; a < 2; ++a)
#pragma unroll
            for (int b = 0; b < 2; ++b)
#pragma unroll
                for (int m = 0; m < 4; ++m)
#pragma unroll
                    for (int n = 0; n < 2; ++n) acc[a][b][m][n] = (f32x4){0.f, 0.f, 0.f, 0.f};
        cur = nxt; cA = nA; cB = nB; ++ui;
        if constexpr (ALIGN_EPI) { if (wr == 1) PG8_BAR; }
    }
    PG8_WAIT_V(0);
    if constexpr (!ALIGN_EPI) { if (wr == 0) PG8_BAR; }
    PG8_BAR;
    if constexpr (Epi::AFTER_DRAIN) { E.fused(acc, cur, wr, wc, fr, fq, lds, wid, lane); S.done(cur); }
#undef PG8_SA
#undef PG8_SB
#undef PG8_STAGE
#undef PG8_LDA
#undef PG8_LDB
#undef PG8_MMA
#undef PG8_WAIT_V
#undef PG8_WAIT_L
#undef PG8_BAR
#undef PG8_SCHED
}
}

#ifndef ATT_KPRELOAD
#define ATT_KPRELOAD 1
#endif
#ifndef ATT_KEARLY
#define ATT_KEARLY 1
#endif
#ifndef ATT_STAGE_LATE
#define ATT_STAGE_LATE 6
#endif
#ifndef ATT_STEP_VPIPE
#define ATT_STEP_VPIPE 1
#endif
#ifndef ATT_STEP
#define ATT_STEP 0
#endif
namespace att {
using bf16 = unsigned short;
using bf16x8 = __attribute__((ext_vector_type(8))) short;
using s16x4  = __attribute__((ext_vector_type(4))) short;
using f32x16 = __attribute__((ext_vector_type(16))) float;
using u32x4  = __attribute__((ext_vector_type(4))) unsigned;
constexpr int NW = 8, QBLK = 32, KVBLK = 64;
constexpr int LROWS = 16400;
constexpr int NT = 257;
constexpr float THR = 8.f;
constexpr int SHM_V = KVBLK * 128 * 2;
constexpr int K_OFF = 4 * SHM_V, WS_OFF = K_OFF + 4 * KVBLK * 128 * 2, ATT_LDS = WS_OFF + NW * 64 * 4;
static_assert(2 * KVBLK * 192 * 2 <= 4 * KVBLK * 128 * 2, "K region");
#define SBAR() __builtin_amdgcn_sched_barrier(0)
__device__ __forceinline__ int crow(int r, int hi) { return (r & 3) + 8 * (r >> 2) + 4 * hi; }
__device__ __forceinline__ unsigned cvtpk(float lo, float hi) { unsigned r; asm volatile("v_cvt_pk_bf16_f32 %0, %1, %2" : "=v"(r) : "v"(lo), "v"(hi)); return r; }
__device__ __forceinline__ bf16x8 ld8(const bf16* p) { return *reinterpret_cast<const bf16x8*>(p); }

template <bool FIXM>
__device__ __forceinline__ void partialSM(f32x16& p0, f32x16& p1, float& m_reg, float& mn, float& alpha, const float C, const float thrS, const int kb, const int hi) {
  if constexpr (FIXM) {
#pragma unroll
    for (int r = 0; r < 16; ++r) p0[r] = __builtin_amdgcn_exp2f(p0[r]);
    if (kb + KVBLK > LROWS) {
#pragma unroll
      for (int r = 0; r < 16; ++r) { if (kb + crow(r, hi) >= LROWS) p0[r] = 0.f; }
    }
    return;
  }
  if (kb + KVBLK > LROWS) {
#pragma unroll
    for (int r = 0; r < 16; ++r) { const int k0 = kb + crow(r, hi); if (k0 >= LROWS) p0[r] = -1e30f; if (k0 + 32 >= LROWS) p1[r] = -1e30f; }
  }
  float pmax = p0[0];
#pragma unroll
  for (int r = 1; r < 16; ++r) pmax = fmaxf(pmax, p0[r]);
#pragma unroll
  for (int r = 0; r < 16; ++r) pmax = fmaxf(pmax, p1[r]);
  { auto rr = __builtin_amdgcn_permlane32_swap(__float_as_uint(pmax), __float_as_uint(pmax), false, false);
    pmax = fmaxf(__uint_as_float(rr[0]), __uint_as_float(rr[1])); }
  if (__builtin_expect(__all(pmax - m_reg <= thrS), 1)) { mn = m_reg; alpha = 1.f; }
  else { mn = fmaxf(m_reg, pmax); alpha = __builtin_amdgcn_exp2f((m_reg - mn) * C); m_reg = mn; }
  const float mnC = -mn * C;
#pragma unroll
  for (int r = 0; r < 16; ++r) p0[r] = fmaf(p0[r], C, mnC);
#pragma unroll
  for (int r = 0; r < 16; ++r) p1[r] = fmaf(p1[r], C, mnC);
#pragma unroll
  for (int r = 0; r < 16; ++r) p0[r] = __builtin_amdgcn_exp2f(p0[r]);
}
template <bool FIXM>
__device__ __forceinline__ void finishSM(f32x16& p0, f32x16& p1, float alpha, float& l_reg, bf16x8& pa0, bf16x8& pa1, bf16x8& pa2, bf16x8& pa3, const int kb, const int hi) {
#pragma unroll
  for (int r = 0; r < 16; ++r) p1[r] = __builtin_amdgcn_exp2f(p1[r]);
  if constexpr (FIXM) { if (kb + KVBLK > LROWS) {
#pragma unroll
    for (int r = 0; r < 16; ++r) { if (kb + 32 + crow(r, hi) >= LROWS) p1[r] = 0.f; } } }
  float ps = 0;
#pragma unroll
  for (int r = 0; r < 16; ++r) ps += p0[r];
#pragma unroll
  for (int r = 0; r < 16; ++r) ps += p1[r];
  if constexpr (FIXM) l_reg += ps; else l_reg = l_reg * alpha + ps;
#define PK4(P, BASE, OUT) do { unsigned a0 = cvtpk(P[BASE + 0], P[BASE + 1]), a1 = cvtpk(P[BASE + 2], P[BASE + 3]);   \
    unsigned b0 = cvtpk(P[BASE + 4], P[BASE + 5]), b1 = cvtpk(P[BASE + 6], P[BASE + 7]);                              \
    u32x4 w = {a0, a1, b0, b1}; OUT = *reinterpret_cast<bf16x8*>(&w); } while (0)
  PK4(p0, 0, pa0); PK4(p0, 8, pa1); PK4(p1, 0, pa2); PK4(p1, 8, pa3);
#undef PK4
}
#define KSWZ(KP, row, colB) ((row) * (KP) + ((colB) ^ ((KP) == 256 ? (((row) & 15) << 4) : ((((row) >> 1) & 7) << 4))))
template <int DQK>
__device__ __forceinline__ void qkt(f32x16& p0, f32x16& p1, const char* Ks, const bf16x8* qr, int r32, int hi) {
  constexpr int KP = DQK * 2;
  p0 = f32x16{}; p1 = f32x16{};
  if constexpr (DQK == 64 && ATT_KPRELOAD) {
    bf16x8 ka[4], kq[4];
#pragma unroll
    for (int d0 = 0; d0 < 4; ++d0) { const int cb = (d0 * 16 + hi * 8) * 2;
      ka[d0] = *reinterpret_cast<const bf16x8*>(Ks + KSWZ(KP, r32, cb)); kq[d0] = *reinterpret_cast<const bf16x8*>(Ks + KSWZ(KP, 32 + r32, cb)); }
    SBAR();
#pragma unroll
    for (int d0 = 0; d0 < 4; ++d0) { p0 = __builtin_amdgcn_mfma_f32_32x32x16_bf16(ka[d0], qr[d0], p0, 0, 0, 0); p1 = __builtin_amdgcn_mfma_f32_32x32x16_bf16(kq[d0], qr[d0], p1, 0, 0, 0); }
    return;
  }
#pragma unroll
  for (int d0 = 0; d0 < DQK / 16; ++d0) { const int cb = (d0 * 16 + hi * 8) * 2;
    bf16x8 b0 = *reinterpret_cast<const bf16x8*>(Ks + KSWZ(KP, r32, cb));
    bf16x8 b1 = *reinterpret_cast<const bf16x8*>(Ks + KSWZ(KP, 32 + r32, cb));
    p0 = __builtin_amdgcn_mfma_f32_32x32x16_bf16(b0, qr[d0], p0, 0, 0, 0);
    p1 = __builtin_amdgcn_mfma_f32_32x32x16_bf16(b1, qr[d0], p1, 0, 0, 0); }
}
__device__ __forceinline__ int v_st(int k, int c) { const int kk = k; return ((kk >> 3) * 4 + (c >> 5)) * 512 + ((kk & 7) * 32 + (c & 31)) * 2; }
__device__ __forceinline__ int v_rd_base(int lane) { return ((lane & 3) << 3) | (((lane >> 2) & 3) << 6) | (((lane >> 4) & 1) << 5) | (((lane >> 5) & 1) << 8); }
constexpr int v_rd_off(int d0, int ks, int half) { return d0 * 512 + ks * 4096 + half * 2048; }
template <int OFF> __device__ __forceinline__ s16x4 tr_read(int vb) {
  s16x4 r; asm volatile("ds_read_b64_tr_b16 %0, %1 offset:%2" : "=&v"(r) : "v"(vb), "i"(OFF) : "memory"); return r;
}
template <int D0> __device__ __forceinline__ void pv_one(f32x16& od, int vb, bf16x8 pa0, bf16x8 pa1, bf16x8 pa2, bf16x8 pa3) {
  const s16x4 l0 = tr_read<v_rd_off(D0, 0, 0)>(vb), h0 = tr_read<v_rd_off(D0, 0, 1)>(vb), l1 = tr_read<v_rd_off(D0, 1, 0)>(vb), h1 = tr_read<v_rd_off(D0, 1, 1)>(vb);
  const s16x4 l2 = tr_read<v_rd_off(D0, 2, 0)>(vb), h2 = tr_read<v_rd_off(D0, 2, 1)>(vb), l3 = tr_read<v_rd_off(D0, 3, 0)>(vb), h3 = tr_read<v_rd_off(D0, 3, 1)>(vb);
  asm volatile("s_waitcnt lgkmcnt(0)" ::: "memory"); SBAR();
#define PK(L, H) (bf16x8){L[0], L[1], L[2], L[3], H[0], H[1], H[2], H[3]}
  od = __builtin_amdgcn_mfma_f32_32x32x16_bf16(pa0, PK(l0, h0), od, 0, 0, 0);
  od = __builtin_amdgcn_mfma_f32_32x32x16_bf16(pa1, PK(l1, h1), od, 0, 0, 0);
  od = __builtin_amdgcn_mfma_f32_32x32x16_bf16(pa2, PK(l2, h2), od, 0, 0, 0);
  od = __builtin_amdgcn_mfma_f32_32x32x16_bf16(pa3, PK(l3, h3), od, 0, 0, 0);
#undef PK
}
__device__ __forceinline__ void pv_d0(f32x16* o, int vb, bf16x8 pa0, bf16x8 pa1, bf16x8 pa2, bf16x8 pa3) {
  pv_one<0>(o[0], vb, pa0, pa1, pa2, pa3); pv_one<1>(o[1], vb, pa0, pa1, pa2, pa3); pv_one<2>(o[2], vb, pa0, pa1, pa2, pa3); pv_one<3>(o[3], vb, pa0, pa1, pa2, pa3);
}
__device__ __forceinline__ float bf2f(unsigned short b) { return __uint_as_float((unsigned)b << 16); }
__device__ __forceinline__ unsigned f2bf(float f) { unsigned u = __float_as_uint(f); return (u + 0x7fffu + ((u >> 16) & 1u)) >> 16; }
struct VF { s16x4 l0, h0, l1, h1, l2, h2, l3, h3; };
template <int D0> __device__ __forceinline__ void v_issue(VF& f, int vb) {
  f.l0 = tr_read<v_rd_off(D0, 0, 0)>(vb); f.h0 = tr_read<v_rd_off(D0, 0, 1)>(vb); f.l1 = tr_read<v_rd_off(D0, 1, 0)>(vb); f.h1 = tr_read<v_rd_off(D0, 1, 1)>(vb);
  f.l2 = tr_read<v_rd_off(D0, 2, 0)>(vb); f.h2 = tr_read<v_rd_off(D0, 2, 1)>(vb); f.l3 = tr_read<v_rd_off(D0, 3, 0)>(vb); f.h3 = tr_read<v_rd_off(D0, 3, 1)>(vb);
}
__device__ __forceinline__ void pv_mma(f32x16& od, const VF& f, bf16x8 pa0, bf16x8 pa1, bf16x8 pa2, bf16x8 pa3) {
#define PK(L, H) (bf16x8){L[0], L[1], L[2], L[3], H[0], H[1], H[2], H[3]}
  od = __builtin_amdgcn_mfma_f32_32x32x16_bf16(pa0, PK(f.l0, f.h0), od, 0, 0, 0);
  od = __builtin_amdgcn_mfma_f32_32x32x16_bf16(pa1, PK(f.l1, f.h1), od, 0, 0, 0);
  od = __builtin_amdgcn_mfma_f32_32x32x16_bf16(pa2, PK(f.l2, f.h2), od, 0, 0, 0);
  od = __builtin_amdgcn_mfma_f32_32x32x16_bf16(pa3, PK(f.l3, f.h3), od, 0, 0, 0);
#undef PK
}
__device__ __forceinline__ void pv_pipe(f32x16* o, int vb, VF& f0, VF& f1, bf16x8 pa0, bf16x8 pa1, bf16x8 pa2, bf16x8 pa3) {
  v_issue<1>(f1, vb); asm volatile("s_waitcnt lgkmcnt(8)" ::: "memory"); SBAR(); pv_mma(o[0], f0, pa0, pa1, pa2, pa3); SBAR();
  v_issue<2>(f0, vb); asm volatile("s_waitcnt lgkmcnt(8)" ::: "memory"); SBAR(); pv_mma(o[1], f1, pa0, pa1, pa2, pa3); SBAR();
  v_issue<3>(f1, vb); asm volatile("s_waitcnt lgkmcnt(8)" ::: "memory"); SBAR(); pv_mma(o[2], f0, pa0, pa1, pa2, pa3); SBAR();
  asm volatile("s_waitcnt lgkmcnt(0)" ::: "memory"); SBAR(); pv_mma(o[3], f1, pa0, pa1, pa2, pa3);
}

template <int DQK, int SDEPTH, int MODE, int PIPE, int ldq, int ldk, int ldv, int ldo, int ldy, int ldg, bool SPLIT = false, bool FIXM = false, bool KVT2 = false>
__device__ __forceinline__ void attn_unit(const int wave_s, const bf16* __restrict__ Qb, const bf16* __restrict__ Kh, const bf16* __restrict__ Vh,
                                          const float scale, const int nvalid, float* __restrict__ Of, bf16* __restrict__ Yb,
                                          const bf16* __restrict__ Gb, char* lds, const int kb0_ = 0, const int nt_ = NT, float* __restrict__ part = nullptr) {
  const int kb0 = SPLIT ? kb0_ : 0, nt = SPLIT ? nt_ : NT;
  Kh += (long)kb0 * ldk; Vh += (long)kb0 * ldv;
  constexpr int ND0 = DQK / 16, KP = DQK * 2, SHM_K = KVBLK * KP, KPT = DQK / 64, NKP = DQK / 8;
  int tid_ = TIDX; asm volatile("" : "+v"(tid_));
  const int tid = tid_, wid = tid >> 6, lane = tid & 63, r32 = lane & 31, hi = lane >> 5;
  char* V_lds = lds; char* K_lds = lds + K_OFF;
  float* ws = (float*)(lds + WS_OFF) + wid * 64; float* li_l = ws; float* al_l = ws + 32;
  const float C = scale * 1.4426950408889634f, thrS = THR / scale;
  float m_reg = -1e30f, l_reg = 0; f32x16 o[4] = {}; bf16x8 qr[ND0];
  const bf16* Qw = Qb + (long)(wid * QBLK + r32) * ldq + hi * 8;
#pragma unroll
  for (int d0 = 0; d0 < ND0; ++d0) qr[d0] = ld8(Qw + d0 * 16);
  const int sr = tid >> 4, sc = (tid & 15) * 8, vst0 = v_st(sr, sc), vst1 = v_st(32 + sr, sc);
  const int vg0 = sr * ldv + sc, vg1 = (32 + sr) * ldv + sc;
  int kst[KPT], kg[KPT];
#pragma unroll
  for (int i = 0; i < KPT; ++i) { const int p = tid + 512 * i, row = p / NKP, cp = p % NKP; kst[i] = KSWZ(KP, row, cp * 16); kg[i] = row * ldk + cp * 8; }
  const int vb0 = (int)(uintptr_t)V_lds + v_rd_base(lane);
  struct { bf16x8 vs0, vs1, ks[KPT]; } sr_[SDEPTH];
  const __amdgpu_buffer_rsrc_t rsK = __builtin_amdgcn_make_buffer_rsrc((void*)Kh, 0, 0x7fffffff, 0x00020000);
  const __amdgpu_buffer_rsrc_t rsV = __builtin_amdgcn_make_buffer_rsrc((void*)Vh, 0, 0x7fffffff, 0x00020000);
#define BLD(rs, voff, soff) __builtin_bit_cast(bf16x8, __builtin_amdgcn_raw_buffer_load_b128((rs), (voff), (soff), 0))
#define SLOAD(i, k0) do { const int sv_ = (k0) * (ldv * 2), sk_ = (k0) * (ldk * 2); sr_[i].vs0 = BLD(rsV, vg0 * 2, sv_); sr_[i].vs1 = BLD(rsV, vg1 * 2, sv_); \
    _Pragma("unroll") for (int q_ = 0; q_ < KPT; ++q_) sr_[i].ks[q_] = BLD(rsK, kg[q_] * 2, sk_); } while (0)
#define SWRITE(b, i) do { *(bf16x8*)(V_lds + (b) * SHM_V + vst0) = sr_[i].vs0; *(bf16x8*)(V_lds + (b) * SHM_V + vst1) = sr_[i].vs1; \
    _Pragma("unroll") for (int q_ = 0; q_ < KPT; ++q_) *(bf16x8*)(K_lds + (b) * SHM_K + kst[q_]) = sr_[i].ks[q_]; } while (0)
#define SWAIT() do { if constexpr (SDEPTH == 2) { if constexpr (KPT == 1) asm volatile("s_waitcnt vmcnt(3)" ::: "memory"); else if constexpr (KPT == 2) asm volatile("s_waitcnt vmcnt(4)" ::: "memory"); else asm volatile("s_waitcnt vmcnt(5)" ::: "memory"); } \
    else asm volatile("s_waitcnt vmcnt(0)" ::: "memory"); } while (0)
#define RESC(a) do { if constexpr (!FIXM) if (__any((a) < 1.f)) { if (hi == 0) al_l[r32] = (a); asm volatile("s_waitcnt lgkmcnt(0)" ::: "memory"); \
    _Pragma("unroll") for (int d = 0; d < 4; ++d) _Pragma("unroll") for (int r = 0; r < 16; ++r) o[d][r] *= al_l[crow(r, hi)]; } } while (0)
  f32x16 pA0, pA1, pB0, pB1; float mnA, mnB, alA, alB; bf16x8 pa0, pa1, pa2, pa3;
  if constexpr (PIPE == 0 && KVT2) {
    static_assert(SDEPTH == 2 && DQK <= 128, "double tiles need two staging slots and fit LDS only for DQK <= 128");
    const int nd = nt >> 1;
    SLOAD(0, 0); SLOAD(1, KVBLK); asm volatile("s_waitcnt vmcnt(0)" ::: "memory"); SWRITE(0, 0); SWRITE(1, 1); SLOAD(0, 2 * KVBLK); SLOAD(1, 3 * KVBLK);
    for (int jj = 0; jj < nd; ++jj) {
      const int b = jj & 1;
      __syncthreads();
      if (jj + 1 < nd) { SWRITE(2 * (b ^ 1), 0); SWRITE(2 * (b ^ 1) + 1, 1); }
      if (jj + 2 < nd) { SLOAD(0, (2 * jj + 4) * KVBLK); SLOAD(1, (2 * jj + 5) * KVBLK); }
#pragma unroll
      for (int sub = 0; sub < 2; ++sub) {
        const int sb = 2 * b + sub, kb = kb0 + (2 * jj + sub) * KVBLK;
        SBAR(); qkt<DQK>(pA0, pA1, K_lds + sb * SHM_K, qr, r32, hi); SBAR();
        const int vb = vb0 + sb * SHM_V;
        VF f0, f1; v_issue<0>(f0, vb);
        partialSM<FIXM>(pA0, pA1, m_reg, mnA, alA, C, thrS, kb, hi);
        RESC(alA);
        finishSM<FIXM>(pA0, pA1, alA, l_reg, pa0, pa1, pa2, pa3, kb, hi); SBAR();
        pv_pipe(o, vb, f0, f1, pa0, pa1, pa2, pa3);
      }
    }
  } else if constexpr (PIPE == 0 && !SPLIT && ATT_STEP) {
#define SLOADK(k0) do { const bf16* kp_ = Kh + (long)(k0) * ldk; _Pragma("unroll") for (int q_ = 0; q_ < KPT; ++q_) sr_[0].ks[q_] = ld8(kp_ + kg[q_]); } while (0)
#define SLOADV(k0) do { const bf16* vp_ = Vh + (long)(k0) * ldv; sr_[0].vs0 = ld8(vp_ + vg0); sr_[0].vs1 = ld8(vp_ + vg1); } while (0)
#define SWRITEK(b) do { _Pragma("unroll") for (int q_ = 0; q_ < KPT; ++q_) *(bf16x8*)(K_lds + (b) * SHM_K + kst[q_]) = sr_[0].ks[q_]; } while (0)
#define SWRITEV(b) do { *(bf16x8*)(V_lds + (b) * SHM_V + vst0) = sr_[0].vs0; *(bf16x8*)(V_lds + (b) * SHM_V + vst1) = sr_[0].vs1; } while (0)
    SLOADK(0); SLOADV(0); asm volatile("s_waitcnt vmcnt(0)" ::: "memory"); SWRITEK(0); SWRITEV(0); SLOADK(KVBLK); SLOADV(KVBLK);
    if (wave_s >= 4) __syncthreads();
    for (int j = 0; j < nt; ++j) {
      const int b = j & 1;
      __syncthreads();
      if (j + 1 < nt) { SWRITEK(b ^ 1); }
      if (j + 2 < nt) { SLOADK((j + 2) * KVBLK); }
      SBAR(); qkt<DQK>(pA0, pA1, K_lds + b * SHM_K, qr, r32, hi); SBAR();
      __syncthreads();
      if (j + 1 < nt) { SWRITEV(b ^ 1); }
      if (j + 2 < nt) { SLOADV((j + 2) * KVBLK); }
      { const int vb = vb0 + b * SHM_V, kb = kb0 + j * KVBLK;
        if constexpr (DQK != 192 && ATT_STEP_VPIPE) {
          VF f0, f1; v_issue<0>(f0, vb);
          partialSM<FIXM>(pA0, pA1, m_reg, mnA, alA, C, thrS, kb, hi); RESC(alA);
          finishSM<FIXM>(pA0, pA1, alA, l_reg, pa0, pa1, pa2, pa3, kb, hi); SBAR();
          pv_pipe(o, vb, f0, f1, pa0, pa1, pa2, pa3);
        } else {
          partialSM<FIXM>(pA0, pA1, m_reg, mnA, alA, C, thrS, kb, hi); RESC(alA);
          finishSM<FIXM>(pA0, pA1, alA, l_reg, pa0, pa1, pa2, pa3, kb, hi); SBAR();
          pv_d0(o, vb, pa0, pa1, pa2, pa3);
        } }
    }
    if (wave_s < 4) __syncthreads();
#undef SLOADK
#undef SLOADV
#undef SWRITEK
#undef SWRITEV
  } else if constexpr (PIPE == 0) {
    SLOAD(0, 0); asm volatile("s_waitcnt vmcnt(0)" ::: "memory"); SWRITE(0, 0); SLOAD(0, KVBLK);
    for (int j = 0; j < nt; ++j) {
      const int b = j & 1;
      __syncthreads();
      if constexpr (DQK == 64 && ATT_KEARLY) {
        bf16x8 ka[4], kq[4]; const char* Ks = K_lds + b * SHM_K;
#pragma unroll
        for (int d0 = 0; d0 < 4; ++d0) { const int cb = (d0 * 16 + hi * 8) * 2;
          ka[d0] = *reinterpret_cast<const bf16x8*>(Ks + KSWZ(KP, r32, cb)); kq[d0] = *reinterpret_cast<const bf16x8*>(Ks + KSWZ(KP, 32 + r32, cb)); }
        SBAR();
        if constexpr (!(ATT_STAGE_LATE & 1)) { if (j + 1 < nt) { SWRITE(b ^ 1, 0); } if (j + 2 < nt) { SLOAD(0, (j + 2) * KVBLK); } SBAR(); }
        pA0 = f32x16{}; pA1 = f32x16{};
#pragma unroll
        for (int d0 = 0; d0 < 4; ++d0) { pA0 = __builtin_amdgcn_mfma_f32_32x32x16_bf16(ka[d0], qr[d0], pA0, 0, 0, 0); pA1 = __builtin_amdgcn_mfma_f32_32x32x16_bf16(kq[d0], qr[d0], pA1, 0, 0, 0); }
        SBAR();
        if constexpr (ATT_STAGE_LATE & 1) { if (j + 1 < nt) { SWRITE(b ^ 1, 0); } if (j + 2 < nt) { SLOAD(0, (j + 2) * KVBLK); } SBAR(); }
      } else {
      constexpr bool LATE = (DQK == 128) ? ((ATT_STAGE_LATE & 2) != 0) : ((ATT_STAGE_LATE & 4) != 0);
      if constexpr (!LATE) { if (j + 1 < nt) { SWRITE(b ^ 1, 0); } if (j + 2 < nt) { SLOAD(0, (j + 2) * KVBLK); } }
      SBAR(); qkt<DQK>(pA0, pA1, K_lds + b * SHM_K, qr, r32, hi); SBAR();
      if constexpr (LATE) { if (j + 1 < nt) { SWRITE(b ^ 1, 0); } if (j + 2 < nt) { SLOAD(0, (j + 2) * KVBLK); } SBAR(); }
      }
      const int vb = vb0 + b * SHM_V;
      if constexpr (DQK != 192) {
        VF f0, f1; v_issue<0>(f0, vb);
        partialSM<FIXM>(pA0, pA1, m_reg, mnA, alA, C, thrS, kb0 + j * KVBLK, hi);
        RESC(alA);
        finishSM<FIXM>(pA0, pA1, alA, l_reg, pa0, pa1, pa2, pa3, kb0 + j * KVBLK, hi); SBAR();
        pv_pipe(o, vb, f0, f1, pa0, pa1, pa2, pa3);
      } else {
        partialSM<FIXM>(pA0, pA1, m_reg, mnA, alA, C, thrS, kb0 + j * KVBLK, hi);
        RESC(alA);
        finishSM<FIXM>(pA0, pA1, alA, l_reg, pa0, pa1, pa2, pa3, kb0 + j * KVBLK, hi); SBAR();
        pv_d0(o, vb, pa0, pa1, pa2, pa3);
      }
    }
  } else {
  constexpr int SE = 0, SO = SDEPTH - 1;
  SLOAD(SE, 0); asm volatile("s_waitcnt vmcnt(0)" ::: "memory"); SWRITE(0, SE); __syncthreads();
  qkt<DQK>(pA0, pA1, K_lds, qr, r32, hi); partialSM<FIXM>(pA0, pA1, m_reg, mnA, alA, C, thrS, kb0, hi);
  SLOAD(SO, KVBLK); if constexpr (SDEPTH == 2) { SLOAD(SE, 2 * KVBLK); }
  SWAIT(); SWRITE(1, SO); __syncthreads();
  for (int j = 1; j + 1 < nt; j += 2) {
    SBAR(); qkt<DQK>(pB0, pB1, K_lds + SHM_K, qr, r32, hi);
    finishSM<FIXM>(pA0, pA1, alA, l_reg, pa0, pa1, pa2, pa3, kb0 + (j - 1) * KVBLK, hi); SBAR();
    SLOAD(SO, (j + SDEPTH) * KVBLK); SBAR();
    pv_d0(o, vb0, pa0, pa1, pa2, pa3); partialSM<FIXM>(pB0, pB1, m_reg, mnB, alB, C, thrS, kb0 + j * KVBLK, hi);
    __syncthreads(); SWAIT(); SWRITE(0, SE);
    RESC(alB); __syncthreads();
    SBAR(); qkt<DQK>(pA0, pA1, K_lds, qr, r32, hi);
    finishSM<FIXM>(pB0, pB1, alB, l_reg, pa0, pa1, pa2, pa3, kb0 + j * KVBLK, hi); SBAR();
    if (SDEPTH == 1 || j + 3 < nt) SLOAD(SE, (j + 1 + SDEPTH) * KVBLK); SBAR();
    pv_d0(o, vb0 + SHM_V, pa0, pa1, pa2, pa3); partialSM<FIXM>(pA0, pA1, m_reg, mnA, alA, C, thrS, kb0 + (j + 1) * KVBLK, hi);
    __syncthreads(); SWAIT(); SWRITE(1, SO);
    RESC(alA); __syncthreads();
  }
  SBAR(); qkt<DQK>(pB0, pB1, K_lds + SHM_K, qr, r32, hi);
  finishSM<FIXM>(pA0, pA1, alA, l_reg, pa0, pa1, pa2, pa3, kb0 + (nt - 2) * KVBLK, hi); SBAR();
  pv_d0(o, vb0, pa0, pa1, pa2, pa3); partialSM<FIXM>(pB0, pB1, m_reg, mnB, alB, C, thrS, kb0 + (nt - 1) * KVBLK, hi);
  __syncthreads(); RESC(alB);
  finishSM<FIXM>(pB0, pB1, alB, l_reg, pa0, pa1, pa2, pa3, kb0 + (nt - 1) * KVBLK, hi); SBAR();
  pv_d0(o, vb0 + SHM_V, pa0, pa1, pa2, pa3);
  }
  { auto rr = __builtin_amdgcn_permlane32_swap(__float_as_uint(l_reg), __float_as_uint(l_reg), false, false);
    l_reg = __uint_as_float(rr[0]) + __uint_as_float(rr[1]); }
  if constexpr (SPLIT) if (part != nullptr) {
    if (wid == 0) {
#pragma unroll
      for (int r = 0; r < 16; ++r) { const int orow = crow(r, hi);
        if (orow < 16) {
#pragma unroll
          for (int d0 = 0; d0 < 4; ++d0) part[orow * 132 + d0 * 32 + r32] = o[d0][r]; } }
      if (hi == 0 && r32 < 16) { part[r32 * 132 + 128] = m_reg; part[r32 * 132 + 129] = l_reg; }
    }
    __syncthreads();
    return;
  }
  if (hi == 0) li_l[r32] = l_reg; asm volatile("s_waitcnt lgkmcnt(0)" ::: "memory");
#pragma unroll
  for (int r = 0; r < 16; ++r) { const int orow = wid * QBLK + crow(r, hi); const float rli = __builtin_amdgcn_rcpf(li_l[crow(r, hi)]);
    if (orow < nvalid) {
      if constexpr (MODE == 0) {
#pragma unroll
        for (int d0 = 0; d0 < 4; ++d0) Of[(long)orow * ldo + d0 * 32 + r32] = o[d0][r] * rli;
      } else {
#pragma unroll
        for (int d0 = 0; d0 < 4; ++d0) { const float g = bf2f(Gb[(long)orow * ldg + d0 * 32 + r32]); const float sg = g / (1.f + __expf(-g));
          Yb[(long)orow * ldy + d0 * 32 + r32] = (bf16)f2bf(o[d0][r] * rli * sg); }
      }
    } }
  __syncthreads();
#undef SLOAD
#undef SWRITE
#undef SWAIT
#undef RESC
}
}

#define LAS __attribute__((address_space(3)))
typedef unsigned short bf16_t;
typedef float f32x4 __attribute__((ext_vector_type(4)));
typedef unsigned u32x4 __attribute__((ext_vector_type(4)));
typedef unsigned u32x2 __attribute__((ext_vector_type(2)));
constexpr int DM = 2048, SEQ = 16384, NMETA = 16, LROWS = SEQ + NMETA, MP = 16640  , DEPTH = 2;
constexpr int INC = 5824, INP = 5888;
constexpr float EPS = 1e-6f;
constexpr int C_AQ = 0, C_AK = 512, C_AV = 1024, C_AG = 1536, C_BQ = 2048, C_BK = 2560, C_BV = 2816, C_BG = 3072,
              C_CQ = 3584, C_CKV = 3968, C_CKR = 4224, C_CG = 4288, C_DU = 4800, C_DG = 5312;
constexpr size_t MiB = 1u << 20;
constexpr size_t al256(size_t x) { return (x + 255) / 256 * 256; }
constexpr size_t WS_CTL = 0;
constexpr size_t WS_XMETA = 4096;
constexpr size_t WS_BAR = 256 * 1024;
constexpr size_t WS_PART = 512 * 1024;
constexpr size_t WS_WIN = 2 * MiB;
constexpr size_t WS_WOUT = WS_WIN + al256((size_t)DEPTH * INP * DM * 2);
constexpr size_t WS_WUQ = WS_WOUT + al256((size_t)DEPTH * DM * DM * 2);
constexpr size_t WS_WUKV = WS_WUQ + al256((size_t)DEPTH * 768 * 384 * 2);
constexpr size_t WS_WD = WS_WUKV + al256((size_t)DEPTH * 1024 * 256 * 2);
constexpr size_t WS_HY = WS_WD + al256((size_t)DEPTH * 512 * 512 * 2);
constexpr size_t WS_P = WS_HY + al256((size_t)MP * DM * 2);
constexpr size_t WS_POOL = WS_P + al256((size_t)MP * INP * 2);
constexpr size_t WS_QC = WS_POOL + al256((size_t)MP * 512 * 2);
constexpr size_t WS_KVC = WS_QC + al256((size_t)MP * 768 * 2);
constexpr size_t WS_KC = WS_KVC + al256((size_t)MP * 1024 * 2);
constexpr size_t WS_OA = WS_KC + al256((size_t)MP * 768 * 2);
constexpr size_t WS_END = WS_OA + al256((size_t)MP * 1024 * 4);

constexpr float LOG2E = 1.4426950408889634f, LN2 = 0.6931471805599453f;
constexpr float QS_A = 0.125f * LOG2E, QS_B = 0.08838834764831845f * LOG2E, QS_C = 0.07216878364870323f * LOG2E;
struct Params {
  const float *x, *meta, *norm_w, *w_in, *w_out, *a_q_norm, *a_k_norm, *a_lambda, *a_subln, *b_q_norm, *b_k_norm,
              *c_q_lat, *c_kv_lat, *c_w_uq, *c_w_ukv, *c_q_norm, *c_k_norm, *d_w_group, *d_scale;
  float* out; unsigned char* ws;
  float inv_a[8], inv_b[32], inv_c[32];
};

__device__ __forceinline__ float bf2f(unsigned short b) { return __uint_as_float((unsigned)b << 16); }
__device__ __forceinline__ float bflo(unsigned w) { return __uint_as_float(w << 16); }
__device__ __forceinline__ float bfhi(unsigned w) { return __uint_as_float(w & 0xffff0000u); }
__device__ __forceinline__ unsigned f2bf(float f) { unsigned u = __float_as_uint(f); return (u + 0x7fffu + ((u >> 16) & 1u)) >> 16; }
__device__ __forceinline__ unsigned pk2(float lo, float hi) { return f2bf(lo) | (f2bf(hi) << 16); }
__device__ __forceinline__ float silu(float g) { return g / (1.f + __expf(-g)); }
__device__ __forceinline__ float wave_sum(float v) {
#pragma unroll
  for (int o = 1; o < 64; o <<= 1) v += __shfl_xor(v, o);
  return v;
}
__device__ __forceinline__ float wave_max(float v) {
#pragma unroll
  for (int o = 1; o < 64; o <<= 1) v = fmaxf(v, __shfl_xor(v, o));
  return v;
}
__device__ __forceinline__ float sum16(float v) { v += __shfl_xor(v, 1); v += __shfl_xor(v, 2); v += __shfl_xor(v, 4); v += __shfl_xor(v, 8); return v; }
__device__ __forceinline__ void rope_cs(float pos, float inv, float& c, float& s) {
  const float ang = pos * inv;
  double rev = (double)ang * 0.15915494309189535; rev -= rint(rev);
  const float fr = (float)rev;
  s = __builtin_amdgcn_sinf(fr); c = __builtin_amdgcn_cosf(fr);
}
__device__ __forceinline__ void unpack8(const u32x4 w, float* x) { x[0] = bflo(w.x); x[1] = bfhi(w.x); x[2] = bflo(w.y); x[3] = bfhi(w.y); x[4] = bflo(w.z); x[5] = bfhi(w.z); x[6] = bflo(w.w); x[7] = bfhi(w.w); }
__device__ __forceinline__ u32x4 pack8(const float* x) { u32x4 w; w.x = pk2(x[0], x[1]); w.y = pk2(x[2], x[3]); w.z = pk2(x[4], x[5]); w.w = pk2(x[6], x[7]); return w; }

#define XB_TMO      128
#define XB_XCNT(j)  (256  + 64 * (j))
#define XB_XSUB(j)  (1280 + 64 * (j))
#define XB_XGEN(j)  (2304 + 64 * (j))
#define XB_TOP      3328
#define XB_TOPGEN   3392
#define XCD_BAR_WORDS 3456
#define XB_SPIN_CAP (1u << 18)

__device__ __forceinline__ unsigned xb_ld(unsigned* p)              { return __hip_atomic_load(p, __ATOMIC_RELAXED, __HIP_MEMORY_SCOPE_AGENT); }
__device__ __forceinline__ unsigned xb_add(unsigned* p, unsigned v) { return __hip_atomic_fetch_add(p, v, __ATOMIC_RELAXED, __HIP_MEMORY_SCOPE_AGENT); }
__device__ __forceinline__ unsigned xb_xcc_id() { return (unsigned)__builtin_amdgcn_s_getreg((3 << 11) | 20) & 0xFu; }
#define XB_SPIN(cond, bar) do { unsigned _sp = 0; while (cond) { __builtin_amdgcn_s_sleep(1); \
    if ((++_sp & 255u) == 0u) { if (xb_ld(&(bar)[XB_TMO])) break; if (_sp > XB_SPIN_CAP) { atomicAdd(&(bar)[XB_TMO], 1u); break; } } } } while (0)

struct XcdBarrier {
    unsigned* bar; unsigned x;
    volatile LAS unsigned* st;
};

__device__ __forceinline__ XcdBarrier xcd_barrier_post(unsigned* bar, volatile LAS unsigned* st, const int wave_s) {
    XcdBarrier b; b.bar = bar; b.x = xb_xcc_id(); b.st = st;
    if (TIDX == 0) (void)xb_add(&bar[XB_XCNT(b.x)], 1u);
    return b;
}
__device__ __forceinline__ void xcd_barrier_complete(unsigned* bar, unsigned x, unsigned& nloc, unsigned& nx) {
    const unsigned G = gridDim.x * gridDim.y * gridDim.z;
    unsigned sum, cnt, mine, sp = 0u;
    for (;;) {
        sum = 0u; cnt = 0u; mine = 0u;
#pragma unroll
        for (unsigned j = 0; j < 16; ++j) { const unsigned c = xb_ld(&bar[XB_XCNT(j)]); sum += c; cnt += (c > 0u) ? 1u : 0u; mine = (j == x) ? c : mine; }
        if (sum == G) break;
        __builtin_amdgcn_s_sleep(1);
        if ((++sp & 255u) == 0u) { if (xb_ld(&bar[XB_TMO])) break; if (sp > XB_SPIN_CAP) { atomicAdd(&bar[XB_TMO], 1u); break; } }
    }
    nloc = mine > 0u ? mine : 1u; nx = cnt > 0u ? cnt : 1u;
}

__device__ __forceinline__ void xcd_barrier(const XcdBarrier& b, const int wave_s) {
    asm volatile("s_waitcnt vmcnt(0)" ::: "memory");
    __syncthreads();
    if (TIDX == 0) {
        unsigned* bar = b.bar;
        __builtin_amdgcn_s_waitcnt(0);
        unsigned nloc = b.st[0], nx = b.st[1];
        if (nloc == 0u) { xcd_barrier_complete(bar, b.x, nloc, nx); b.st[0] = nloc; b.st[1] = nx; }
        const unsigned old = xb_add(&bar[XB_XSUB(b.x)], 1u);
        const unsigned gen = old / nloc;
        if (old + 1u == (gen + 1u) * nloc) {
            __builtin_amdgcn_fence(__ATOMIC_RELEASE, "agent");
            asm volatile("s_waitcnt vmcnt(0)" ::: "memory");
            const unsigned og = xb_add(&bar[XB_TOP], 1u);
            const unsigned tg = og / nx;
            if (og + 1u == (tg + 1u) * nx) xb_add(&bar[XB_TOPGEN], 1u);
            else XB_SPIN(xb_ld(&bar[XB_TOPGEN]) == tg, bar);
            __builtin_amdgcn_fence(__ATOMIC_ACQUIRE, "agent");
            xb_add(&bar[XB_XGEN(b.x)], 1u);
            asm volatile("s_waitcnt vmcnt(0)" ::: "memory");
        } else {
            XB_SPIN(xb_ld(&bar[XB_XGEN(b.x)]) == gen, bar);
            __builtin_amdgcn_fence(__ATOMIC_ACQUIRE, "agent");
            asm volatile("s_waitcnt vmcnt(0)" ::: "memory");
        }
    }
    __syncthreads();
}

__device__ __forceinline__ void tr_item(const float* __restrict__ W, int ldw, int sk0, int sn0, bf16_t* __restrict__ WT, int ldt, int dn0, int dk0, LAS float* scr, int lane, bool zero) {
  if (!zero) {
#pragma unroll 8
    for (int i = 0; i < 32; ++i) { const int kk = 2 * i + (lane >> 5); scr[kk * 33 + (lane & 31)] = W[(size_t)(sk0 + kk) * ldw + sn0 + (lane & 31)]; }
  }
  asm volatile("s_waitcnt lgkmcnt(0)" ::: "memory");
  const int c = lane & 7;
#pragma unroll
  for (int j = 0; j < 4; ++j) { const int n = (lane >> 3) + 8 * j; const LAS float* s = scr + (8 * c) * 33 + n;
    u32x4 o = {0u, 0u, 0u, 0u};
    if (!zero) { o.x = pk2(s[0 * 33], s[1 * 33]); o.y = pk2(s[2 * 33], s[3 * 33]); o.z = pk2(s[4 * 33], s[5 * 33]); o.w = pk2(s[6 * 33], s[7 * 33]); }
    *(u32x4*)(WT + (size_t)(dn0 + n) * ldt + dk0 + 8 * c) = o; }
  asm volatile("s_waitcnt lgkmcnt(0)" ::: "memory");
}

__device__ __forceinline__ void phase_prologue(const Params& p, LAS unsigned char* lds, const int wave_s) {
  int t_ = TIDX; asm volatile("" : "+v"(t_)); const int lane = t_ & 63, wave = __builtin_amdgcn_readfirstlane(t_ >> 6), gw = blockIdx.x * 8 + wave, NGW = gridDim.x * 8; (void)wave;
  LAS float* scr = (LAS float*)(lds + wave * 16384);
  unsigned char* ws = p.ws;
  constexpr int I_IN = (DM / 64) * (INC / 32), I_OUT = (DM / 64) * (DM / 32), I_UQ = (384 / 64) * (768 / 32), I_UKV = (256 / 64) * (1024 / 32), I_D = (512 / 64) * (512 / 32);
  constexpr int I_LAYER = I_IN + I_OUT + I_UQ + I_UKV + I_D;
  for (int it = gw; it < DEPTH * I_LAYER; it += NGW) {
    const int layer = it / I_LAYER; int r = it % I_LAYER;
    if (r < I_IN) { const int nblk = INC / 32, kb = r / nblk, nb = r % nblk;
      tr_item(p.w_in + (size_t)layer * DM * INC, INC, 64 * kb, 32 * nb, (bf16_t*)(ws + WS_WIN) + (size_t)layer * INP * DM, DM, 32 * nb, 64 * kb, scr, lane, false); continue; } r -= I_IN;
    if (r < I_OUT) { const int nblk = DM / 32, kb = r / nblk, nb = r % nblk;
      tr_item(p.w_out + (size_t)layer * DM * DM, DM, 64 * kb, 32 * nb, (bf16_t*)(ws + WS_WOUT) + (size_t)layer * DM * DM, DM, 32 * nb, 64 * kb, scr, lane, false); continue; } r -= I_OUT;
    if (r < I_UQ) { const int nblk = 768 / 32, kb = r / nblk, nb = r % nblk;
      tr_item(p.c_w_uq + (size_t)layer * 384 * 768, 768, 64 * kb, 32 * nb, (bf16_t*)(ws + WS_WUQ) + (size_t)layer * 768 * 384, 384, 32 * nb, 64 * kb, scr, lane, false); continue; } r -= I_UQ;
    if (r < I_UKV) { const int nblk = 1024 / 32, kb = r / nblk, nb = r % nblk;
      tr_item(p.c_w_ukv + (size_t)layer * 256 * 1024, 1024, 64 * kb, 32 * nb, (bf16_t*)(ws + WS_WUKV) + (size_t)layer * 1024 * 256, 256, 32 * nb, 64 * kb, scr, lane, false); continue; } r -= I_UKV;
    { const int nblk = 512 / 32, kb = r / nblk, nb = r % nblk, k0 = 64 * kb, n0 = 32 * nb, gk = k0 >> 7, gn = n0 >> 7;
      tr_item(p.d_w_group + ((size_t)layer * 4 + gk) * 128 * 128, 128, k0 & 127, n0 & 127, (bf16_t*)(ws + WS_WD) + (size_t)layer * 512 * 512, 512, n0, k0, scr, lane, gk != gn); }
  }
  for (int i = gw * 64 + lane; i < DEPTH * (INP - INC) * DM / 8; i += NGW * 64) { const int layer = i / ((INP - INC) * DM / 8), j = i % ((INP - INC) * DM / 8);
    *(u32x4*)((bf16_t*)(ws + WS_WIN) + (size_t)layer * INP * DM + (size_t)INC * DM + (size_t)j * 8) = (u32x4){0u, 0u, 0u, 0u}; }
  if (gw == 0) { ((unsigned*)(ws + WS_CTL))[lane] = 0u; ((unsigned*)(ws + WS_CTL))[64 + lane] = 0u; }
  if (gw < DEPTH) { const int layer = gw, ln = lane; int fastmask;
    const float* aqn = p.a_q_norm + layer * 64; const float* akn = p.a_k_norm + layer * 64; const float* bqn = p.b_q_norm + layer * 128; const float* bkn = p.b_k_norm + layer * 128;
    const float* cqn = p.c_q_norm + layer * 192; const float* ckn = p.c_k_norm + layer * 192;
    const float maq = wave_max(fabsf(aqn[ln])), mak = wave_max(fabsf(akn[ln]));
    const float mbq = wave_max(fmaxf(fabsf(bqn[ln]), fabsf(bqn[64 + ln]))), mbk = wave_max(fmaxf(fabsf(bkn[ln]), fabsf(bkn[64 + ln])));
    const float mcqn = wave_max(fmaxf(fabsf(cqn[ln]), fabsf(cqn[64 + ln]))), mcqr = wave_max(fabsf(cqn[128 + ln]));
    const float mckn = wave_max(fmaxf(fabsf(ckn[ln]), fabsf(ckn[64 + ln]))), mckr = wave_max(fabsf(ckn[128 + ln]));
    const float bA = 64.f * maq * mak * QS_A, bB = 128.f * mbq * mbk * QS_B;
    const float bC = sqrtf((128.f * mcqn * mcqn + 64.f * mcqr * mcqr) * (128.f * mckn * mckn + 64.f * mckr * mckr)) * QS_C;
    fastmask = (bC < 60.f ? 1 : 0) | (bB < 60.f ? 2 : 0) | (bA < 60.f ? 4 : 0);
    if (lane == 0) ((int*)(ws + WS_CTL))[256 + layer] = fastmask; }

  if (blockIdx.x == 0) { for (int i = t_; i < XCD_BAR_WORDS; i += 512) ((unsigned*)(ws + WS_BAR))[i] = 0u; }
}

__device__ __forceinline__ void phase_rmsnorm(const float* __restrict__ src_meta, const float* __restrict__ src_body, const float* __restrict__ w, bf16_t* __restrict__ H, const int wave_s) {
  int t_ = TIDX; asm volatile("" : "+v"(t_)); const int lane = t_ & 63, wave = __builtin_amdgcn_readfirstlane(t_ >> 6), gw = blockIdx.x * 8 + wave, NGW = gridDim.x * 8; (void)wave;
  for (int r = gw; r < MP; r += NGW) {
    u32x2* o8 = (u32x2*)(H + (size_t)r * DM) + lane;
    if (r >= LROWS) {
#pragma unroll
      for (int j = 0; j < 8; ++j) o8[64 * j] = (u32x2){0u, 0u};
      continue; }
    const float* row = (r < NMETA) ? src_meta + (size_t)r * DM : src_body + (size_t)(r - NMETA) * DM;
    const f32x4* xr = (const f32x4*)row + lane; f32x4 v[8]; float ss = 0.f;
#pragma unroll
    for (int j = 0; j < 8; ++j) { v[j] = xr[64 * j]; ss += (v[j].x * v[j].x + v[j].y * v[j].y) + (v[j].z * v[j].z + v[j].w * v[j].w); }
    const float rs = rsqrtf(wave_sum(ss) * (1.f / DM) + EPS);
#pragma unroll
    for (int j = 0; j < 8; ++j) { const f32x4 g = ((const f32x4*)w)[lane + 64 * j];
      o8[64 * j] = (u32x2){pk2(v[j].x * rs * g.x, v[j].y * rs * g.y), pk2(v[j].z * rs * g.z, v[j].w * rs * g.w)}; }
  }
}

__device__ __forceinline__ void phase_post1(const Params& p, int layer, const int wave_s) {
  int t_ = TIDX; asm volatile("" : "+v"(t_)); const int lane = t_ & 63, wave = __builtin_amdgcn_readfirstlane(t_ >> 6), gw = blockIdx.x * 8 + wave, NGW = gridDim.x * 8; (void)wave;
  bf16_t* P = (bf16_t*)(p.ws + WS_P); bf16_t* POOL = (bf16_t*)(p.ws + WS_POOL); bf16_t* KC = (bf16_t*)(p.ws + WS_KC);
  const float* aqn = p.a_q_norm + layer * 64; const float* akn = p.a_k_norm + layer * 64;
  const float* bqn = p.b_q_norm + layer * 128; const float* bkn = p.b_k_norm + layer * 128;
  const float* cql = p.c_q_lat + layer * 384; const float* ckvl = p.c_kv_lat + layer * 256; const float* ckn = p.c_k_norm + layer * 192;
  for (int r = gw; r < MP; r += NGW) {
    if (r >= LROWS) {
      *(u32x4*)(POOL + (size_t)r * 512 + lane * 8) = (u32x4){0u, 0u, 0u, 0u};
      for (int i = lane; i < 768 / 8; i += 64) *(u32x4*)(KC + (size_t)r * 768 + i * 8) = (u32x4){0u, 0u, 0u, 0u};
      continue; }
    bf16_t* pr = P + (size_t)r * INP;
    const float posf = (float)r;
    const float rowp = (r < NMETA) ? -1.f : (float)((r - NMETA) >> 6), colp = (r < NMETA) ? (float)r : (float)((r - NMETA) & 63);
    { float x[16]; u32x4* ptr = (u32x4*)(pr + C_AQ + lane * 16); const u32x4 w0 = ptr[0], w1 = ptr[1]; unpack8(w0, x); unpack8(w1, x + 8);
      float ss = 0.f;
#pragma unroll
      for (int i = 0; i < 16; ++i) ss += x[i] * x[i];
      ss += __shfl_xor(ss, 1); ss += __shfl_xor(ss, 2);
      const float rs = rsqrtf(ss * (1.f / 64.f) + EPS) * ((lane >> 5) ? 1.f : QS_A);
      const float* wn = ((lane >> 5) ? akn : aqn) + (lane & 3) * 16;
#pragma unroll
      for (int i = 0; i < 16; ++i) x[i] = x[i] * rs * wn[i];
      if ((lane & 3) == 0) {
#pragma unroll
        for (int j = 0; j < 8; ++j) { float c, s; rope_cs(posf, p.inv_a[j], c, s); const float x1 = x[j], x2 = x[8 + j]; x[j] = x1 * c - x2 * s; x[8 + j] = x1 * s + x2 * c; }
      }
      ptr[0] = pack8(x); ptr[1] = pack8(x + 8); }
#pragma unroll
    for (int pass = 0; pass < 2; ++pass) {
      const bool act = (pass == 0) || (lane < 32);
      u32x4* ptr = (u32x4*)(pr + (pass == 0 ? C_BQ : C_BK) + lane * 8);
      float x[8]; u32x4 w = {0u, 0u, 0u, 0u}; if (act) w = *ptr; unpack8(w, x);
      float ss = 0.f;
#pragma unroll
      for (int i = 0; i < 8; ++i) ss += x[i] * x[i];
      ss = sum16(ss);
      const float rs = rsqrtf(ss * (1.f / 128.f) + EPS) * (pass == 0 ? QS_B : 1.f);
      const int a = lane & 15; const float* wn = (pass == 0 ? bqn : bkn) + a * 8;
      const float posv = (a < 8) ? rowp : colp;
#pragma unroll
      for (int i = 0; i < 8; ++i) { const float y = x[i] * rs * wn[i]; const float other = __shfl_xor(y, 4);
        float c, s; rope_cs(posv, p.inv_b[(a & 3) * 8 + i], c, s);
        x[i] = (a & 4) ? other * s + y * c : y * c - other * s; }
      if (act) *ptr = pack8(x);
    }
    { unsigned* ptr = (unsigned*)(pr + C_CQ); unsigned w[3]; float ss = 0.f;
#pragma unroll
      for (int j = 0; j < 3; ++j) { w[j] = ptr[lane + 64 * j]; const float a = bflo(w[j]), b = bfhi(w[j]); ss += a * a + b * b; }
      const float rs = rsqrtf(wave_sum(ss) * (1.f / 384.f) + EPS);
#pragma unroll
      for (int j = 0; j < 3; ++j) { const int e = 2 * (lane + 64 * j); ptr[lane + 64 * j] = pk2(bflo(w[j]) * rs * cql[e], bfhi(w[j]) * rs * cql[e + 1]); } }
    { u32x2* ptr = (u32x2*)(pr + C_CKV) + lane; const u32x2 w = *ptr; const float a0 = bflo(w.x), a1 = bfhi(w.x), a2 = bflo(w.y), a3 = bfhi(w.y);
      const float rs = rsqrtf(wave_sum(a0 * a0 + a1 * a1 + a2 * a2 + a3 * a3) * (1.f / 256.f) + EPS);
      const float* g = ckvl + lane * 4;
      *ptr = (u32x2){pk2(a0 * rs * g[0], a1 * rs * g[1]), pk2(a2 * rs * g[2], a3 * rs * g[3])}; }
    { const float xk = bf2f(pr[C_CKR + lane]); const float rs = rsqrtf(wave_sum(xk * xk) * (1.f / 64.f) + EPS);
      const float y = xk * rs * ckn[128 + lane]; const float other = __shfl_xor(y, 32);
      float c, s; rope_cs(posf, p.inv_c[lane & 31], c, s);
      const float o = (lane & 32) ? other * s + y * c : y * c - other * s; const bf16_t ob = (bf16_t)f2bf(o);
#pragma unroll
      for (int h = 0; h < 4; ++h) KC[(size_t)r * 768 + h * 192 + 128 + lane] = ob; }
    { const int hw = 1 << (lane >> 4); const int lo = max(r - hw, 0), hi = min(r + hw, LROWS);
      float acc[8], u[8];
#pragma unroll
      for (int i = 0; i < 8; ++i) acc[i] = 0.f;
      u32x4 wv[16];
#pragma unroll
      for (int j = 0; j < 16; ++j) { const int t = min(max(r - 8 + j, 0), LROWS - 1); wv[j] = *(const u32x4*)(P + (size_t)t * INP + C_DU + lane * 8); }
#pragma unroll
      for (int j = 0; j < 16; ++j) { const int t = r - 8 + j; float x[8]; unpack8(wv[j], x); const bool in = (t >= lo) && (t < hi);
#pragma unroll
        for (int i = 0; i < 8; ++i) acc[i] += in ? x[i] : 0.f;
        if (j == 8) {
#pragma unroll
          for (int i = 0; i < 8; ++i) u[i] = x[i]; } }
      const float inv = 1.f / (float)(hi - lo);
#pragma unroll
      for (int i = 0; i < 8; ++i) acc[i] = acc[i] * inv - u[i];
      *(u32x4*)(POOL + (size_t)r * 512 + lane * 8) = pack8(acc); }
  }
}

__device__ __forceinline__ void phase_post2(const Params& p, int layer, const int wave_s) {
  int t_ = TIDX; asm volatile("" : "+v"(t_)); const int lane = t_ & 63, wave = __builtin_amdgcn_readfirstlane(t_ >> 6), gw = blockIdx.x * 8 + wave, NGW = gridDim.x * 8; (void)wave;
  bf16_t* QC = (bf16_t*)(p.ws + WS_QC); const bf16_t* KVC = (const bf16_t*)(p.ws + WS_KVC); bf16_t* KC = (bf16_t*)(p.ws + WS_KC);
  const float* cqn = p.c_q_norm + layer * 192; const float* ckn = p.c_k_norm + layer * 192;
  const int h = lane >> 4, a = lane & 15;
  for (int r = gw; r < LROWS; r += NGW) {
    const float posf = (float)r;
    { u32x4* ptr = (u32x4*)(QC + (size_t)r * 768 + h * 192 + a * 8); float x[8]; unpack8(*ptr, x); float ss = 0.f;
#pragma unroll
      for (int i = 0; i < 8; ++i) ss += x[i] * x[i];
      const float rs = rsqrtf(sum16(ss) * (1.f / 128.f) + EPS) * QS_C;
#pragma unroll
      for (int i = 0; i < 8; ++i) x[i] = x[i] * rs * cqn[a * 8 + i];
      *ptr = pack8(x); }
    { u32x2* ptr = (u32x2*)(QC + (size_t)r * 768 + h * 192 + 128 + a * 4); const u32x2 w = *ptr; float x[4] = {bflo(w.x), bfhi(w.x), bflo(w.y), bfhi(w.y)};
      const float rs = rsqrtf(sum16(x[0] * x[0] + x[1] * x[1] + x[2] * x[2] + x[3] * x[3]) * (1.f / 64.f) + EPS) * QS_C;
#pragma unroll
      for (int i = 0; i < 4; ++i) { const float y = x[i] * rs * cqn[128 + a * 4 + i]; const float other = __shfl_xor(y, 8);
        float c, s; rope_cs(posf, p.inv_c[(a & 7) * 4 + i], c, s);
        x[i] = (a & 8) ? other * s + y * c : y * c - other * s; }
      *ptr = (u32x2){pk2(x[0], x[1]), pk2(x[2], x[3])}; }
    { float x[8]; unpack8(*(const u32x4*)(KVC + (size_t)r * 1024 + h * 256 + a * 8), x); float ss = 0.f;
#pragma unroll
      for (int i = 0; i < 8; ++i) ss += x[i] * x[i];
      const float rs = rsqrtf(sum16(ss) * (1.f / 128.f) + EPS);
#pragma unroll
      for (int i = 0; i < 8; ++i) x[i] = x[i] * rs * ckn[a * 8 + i];
      *(u32x4*)(KC + (size_t)r * 768 + h * 192 + a * 8) = pack8(x); }
  }
}

__device__ __forceinline__ void meta_combine8(const float* __restrict__ ph, int r, int col0, float C, float* out) {
  float M = -1e30f;
#pragma unroll
  for (int sidx = 0; sidx < 8; ++sidx) M = fmaxf(M, ph[(sidx * 16 + r) * 132 + 128]);
  float l = 0.f, acc[8];
#pragma unroll
  for (int i = 0; i < 8; ++i) acc[i] = 0.f;
#pragma unroll
  for (int sidx = 0; sidx < 8; ++sidx) { const float* pp = ph + (sidx * 16 + r) * 132; const float w = exp2f((pp[128] - M) * C); l += pp[129] * w;
    const f32x4 a = *(const f32x4*)(pp + col0), b = *(const f32x4*)(pp + col0 + 4);
    acc[0] += a.x * w; acc[1] += a.y * w; acc[2] += a.z * w; acc[3] += a.w * w; acc[4] += b.x * w; acc[5] += b.y * w; acc[6] += b.z * w; acc[7] += b.w * w; }
  const float il = 1.f / l;
#pragma unroll
  for (int i = 0; i < 8; ++i) out[i] = acc[i] * il;
}

__device__ __forceinline__ void phase_post3(const Params& p, int layer, float lambda_init, const int wave_s) {
  int t_ = TIDX; asm volatile("" : "+v"(t_)); const int lane = t_ & 63, wave = __builtin_amdgcn_readfirstlane(t_ >> 6), gw = blockIdx.x * 8 + wave, NGW = gridDim.x * 8; (void)wave;
  const bf16_t* P = (const bf16_t*)(p.ws + WS_P); const float* OA = (const float*)(p.ws + WS_OA); bf16_t* Y = (bf16_t*)(p.ws + WS_HY);
  const float* lp = p.a_lambda + layer * 256; const float* sub = p.a_subln + layer * 128; const float* dsc = p.d_scale + layer * 512;
  const float lam = __expf(wave_sum(lp[lane] * lp[64 + lane])) - __expf(wave_sum(lp[128 + lane] * lp[192 + lane])) + lambda_init;
  const float post = 1.f - lambda_init;
  const int h = lane >> 4, a = lane & 15;
  const bool metasplit = (layer != DEPTH - 1);
  const float* PART = (const float*)(p.ws + WS_PART);
  for (int r = gw; r < LROWS; r += NGW) {
    if (metasplit && r < NMETA) {
      float x1[8], x2[8];
      meta_combine8(PART + (size_t)((8 + 2 * h) * 8 * 16) * 132, r, a * 8, 1.f, x1);
      meta_combine8(PART + (size_t)((8 + 2 * h + 1) * 8 * 16) * 132, r, a * 8, 1.f, x2);
      float x[8], ss = 0.f;
#pragma unroll
      for (int i = 0; i < 8; ++i) { x[i] = x1[i] - lam * x2[i]; ss += x[i] * x[i]; }
      const float rs = rsqrtf(sum16(ss) * (1.f / 128.f) + EPS);
      float g[8]; unpack8(*(const u32x4*)(P + (size_t)r * INP + C_AG + h * 128 + a * 8), g);
#pragma unroll
      for (int i = 0; i < 8; ++i) x[i] = x[i] * rs * sub[a * 8 + i] * post * silu(g[i]);
      *(u32x4*)(Y + (size_t)r * DM + h * 128 + a * 8) = pack8(x);
      meta_combine8(PART + (size_t)((4 + h) * 8 * 16) * 132, r, a * 8, 1.f, x1);
      unpack8(*(const u32x4*)(P + (size_t)r * INP + C_BG + h * 128 + a * 8), g);
#pragma unroll
      for (int i = 0; i < 8; ++i) x1[i] *= silu(g[i]);
      *(u32x4*)(Y + (size_t)r * DM + 512 + h * 128 + a * 8) = pack8(x1);
      meta_combine8(PART + (size_t)(h * 8 * 16) * 132, r, a * 8, 1.f, x2);
      unpack8(*(const u32x4*)(P + (size_t)r * INP + C_CG + h * 128 + a * 8), g);
#pragma unroll
      for (int i = 0; i < 8; ++i) x2[i] *= silu(g[i]);
      *(u32x4*)(Y + (size_t)r * DM + 1024 + h * 128 + a * 8) = pack8(x2);
    } else
    { const f32x4* o1 = (const f32x4*)(OA + (size_t)r * 1024 + (2 * h) * 128 + a * 8); const f32x4* o2 = (const f32x4*)(OA + (size_t)r * 1024 + (2 * h + 1) * 128 + a * 8);
      const f32x4 u0 = o1[0], u1 = o1[1], v0 = o2[0], v1 = o2[1];
      float x[8] = {u0.x - lam * v0.x, u0.y - lam * v0.y, u0.z - lam * v0.z, u0.w - lam * v0.w, u1.x - lam * v1.x, u1.y - lam * v1.y, u1.z - lam * v1.z, u1.w - lam * v1.w};
      float ss = 0.f;
#pragma unroll
      for (int i = 0; i < 8; ++i) ss += x[i] * x[i];
      const float rs = rsqrtf(sum16(ss) * (1.f / 128.f) + EPS);
      float g[8]; unpack8(*(const u32x4*)(P + (size_t)r * INP + C_AG + h * 128 + a * 8), g);
#pragma unroll
      for (int i = 0; i < 8; ++i) x[i] = x[i] * rs * sub[a * 8 + i] * post * silu(g[i]);
      *(u32x4*)(Y + (size_t)r * DM + h * 128 + a * 8) = pack8(x); }
    { float m[8], g[8]; unpack8(*(const u32x4*)(P + (size_t)r * INP + C_DU + lane * 8), m); unpack8(*(const u32x4*)(P + (size_t)r * INP + C_DG + lane * 8), g);
#pragma unroll
      for (int i = 0; i < 8; ++i) m[i] = m[i] * dsc[lane * 8 + i] * silu(g[i]);
      *(u32x4*)(Y + (size_t)r * DM + 1536 + lane * 8) = pack8(m); }
  }
}

#ifndef ATT_SD128
#define ATT_SD128 1
#endif
#ifndef ATT_KVT2_A
#define ATT_KVT2_A 0
#endif
#ifndef ATT_KVT2_B
#define ATT_KVT2_B 0
#endif
#ifndef ATT_STEP_VPIPE
#define ATT_STEP_VPIPE 1
#endif
#ifndef ATT_PIPE64
#define ATT_PIPE64 0
#endif
#ifndef ATT_PIPE128
#define ATT_PIPE128 0
#endif
#ifndef ATT_SD192
#define ATT_SD192 1
#endif
#ifndef ATT_PIPE192
#define ATT_PIPE192 0
#endif
__device__ __forceinline__ void phase_attn(const Params& p, int layer, char* lds, int slot, const int wave_s) {
  const bf16_t* P = (const bf16_t*)(p.ws + WS_P); const bf16_t* QC = (const bf16_t*)(p.ws + WS_QC); const bf16_t* KVC = (const bf16_t*)(p.ws + WS_KVC);
  const bf16_t* KC = (const bf16_t*)(p.ws + WS_KC); float* OA = (float*)(p.ws + WS_OA); bf16_t* Y = (bf16_t*)(p.ws + WS_HY);
  unsigned* ctr = (unsigned*)(p.ws + WS_CTL) + slot * 16;
  volatile int* sh = (volatile int*)(lds + att::ATT_LDS);
  const int fastmask = __builtin_amdgcn_readfirstlane(((const int*)(p.ws + WS_CTL))[256 + layer]);
  const int QLEN = (layer == DEPTH - 1) ? 128 : 144;
  float* PART = (float*)(p.ws + WS_PART);
  int q = (int)(__builtin_amdgcn_s_getreg((3 << 11) | 20) & 7u), tried = 0;
  for (;;) {
    __syncthreads();
    if (TIDX == 0) { int u = -1;
      while (tried < 8) { u = (int)__hip_atomic_fetch_add(ctr + q, 1u, __ATOMIC_RELAXED, __HIP_MEMORY_SCOPE_AGENT); if (u < QLEN) break; u = -1; q = (q + 1) & 7; ++tried; }
      sh[0] = u; sh[1] = q; }
    __syncthreads();
    const int u = __builtin_amdgcn_readfirstlane(sh[0]), qx = __builtin_amdgcn_readfirstlane(sh[1]);
    if (u < 0) break;
    int type, h, qb, sp = -1; float* part = nullptr;
    if (u < 128) { const int seg = u >> 5, i = u & 31; if (seg < 2) { type = seg; h = qx >> 1; qb = 32 * (qx & 1) + i; } else { type = 2; h = qx; qb = 32 * (seg - 2) + i; } }
    else { const int m = qx * 16 + (u - 128), hd = m >> 3; sp = m & 7; qb = 64; if (hd < 4) { type = 0; h = hd; } else if (hd < 8) { type = 1; h = hd - 4; } else { type = 2; h = hd - 8; }
      part = PART + (size_t)(m * 16) * 132; }
    const int q0 = qb < 64 ? NMETA + 256 * qb : 0, nv = qb < 64 ? 256 : NMETA;
    const int kb0 = sp < 0 ? 0 : sp * 2048, nt = sp < 0 ? att::NT : (sp == 7 ? att::NT - 7 * 32 : 32);
    if (part != nullptr || !((fastmask >> type) & 1)) {
      if (type == 0) att::attn_unit<192, 1, 1, 0, 768, 768, 1024, 0, DM, INP, true>(wave_s, QC + (size_t)q0 * 768 + h * 192, KC + h * 192, KVC + h * 256 + 128, LN2, nv,
                                nullptr, Y + (size_t)q0 * DM + 1024 + h * 128, P + (size_t)q0 * INP + C_CG + h * 128, lds, kb0, nt, part);
      else if (type == 1) att::attn_unit<128, 1, 1, 0, INP, INP, INP, 0, DM, INP, true>(wave_s, P + (size_t)q0 * INP + C_BQ + h * 128, P + C_BK + (h >> 1) * 128, P + C_BV + (h >> 1) * 128, LN2, nv,
                                nullptr, Y + (size_t)q0 * DM + 512 + h * 128, P + (size_t)q0 * INP + C_BG + h * 128, lds, kb0, nt, part);
      else att::attn_unit<64, 1, 0, 0, INP, INP, INP, 1024, 0, 0, true>(wave_s, P + (size_t)q0 * INP + C_AQ + h * 64, P + C_AK + h * 64, P + C_AV + (h >> 1) * 128, LN2, nv,
                               OA + (size_t)q0 * 1024 + h * 128, nullptr, nullptr, lds, kb0, nt, part);
    } else if (type == 0) {
      att::attn_unit<192, ATT_SD192, 1, ATT_PIPE192, 768, 768, 1024, 0, DM, INP, false, true>(wave_s, QC + (size_t)q0 * 768 + h * 192, KC + h * 192, KVC + h * 256 + 128, LN2, nv,
                                nullptr, Y + (size_t)q0 * DM + 1024 + h * 128, P + (size_t)q0 * INP + C_CG + h * 128, lds);
    } else if (type == 1) {
      att::attn_unit<128, 1 + ATT_KVT2_B, 1, ATT_PIPE128, INP, INP, INP, 0, DM, INP, false, true, ATT_KVT2_B != 0>(wave_s, P + (size_t)q0 * INP + C_BQ + h * 128, P + C_BK + (h >> 1) * 128, P + C_BV + (h >> 1) * 128, LN2, nv,
                                nullptr, Y + (size_t)q0 * DM + 512 + h * 128, P + (size_t)q0 * INP + C_BG + h * 128, lds);
    } else {
      att::attn_unit<64, 1 + ATT_KVT2_A, 0, ATT_PIPE64, INP, INP, INP, 1024, 0, 0, false, true, ATT_KVT2_A != 0>(wave_s, P + (size_t)q0 * INP + C_AQ + h * 64, P + C_AK + h * 64, P + C_AV + (h >> 1) * 128, LN2, nv,
                               OA + (size_t)q0 * 1024 + h * 128, nullptr, nullptr, lds);
    }
  }
}

typedef short bf16x8_t __attribute__((ext_vector_type(8)));
template <class F>
__device__ __forceinline__ void small_gemm16(const bf16_t* __restrict__ A, const int lda, const bf16_t* __restrict__ Bt, const int N, const int K, const F& store, LAS unsigned char* lds, const int wave_s) {
  int t_ = TIDX; asm volatile("" : "+v"(t_)); const int lane = t_ & 63; const int G = gridDim.x;
  LAS f32x4* red = (LAS f32x4*)lds;
  const int kpw = K >> 3, k0 = wave_s * kpw;
  for (int blk = (int)blockIdx.x; blk < N / 16; blk += G) {
    f32x4 acc = {0.f, 0.f, 0.f, 0.f};
    const bf16_t* ap = A + (size_t)(lane & 15) * lda + (lane >> 4) * 8 + k0;
    const bf16_t* bp = Bt + (size_t)(blk * 16 + (lane & 15)) * K + (lane >> 4) * 8 + k0;
#pragma unroll 8
    for (int k = 0; k < kpw; k += 32) acc = __builtin_amdgcn_mfma_f32_16x16x32_bf16(*(const bf16x8_t*)(ap + k), *(const bf16x8_t*)(bp + k), acc, 0, 0, 0);
    red[wave_s * 64 + lane] = acc;
    __syncthreads();
    if (wave_s == 0) {
      f32x4 t = red[lane];
#pragma unroll
      for (int w = 1; w < 8; ++w) t += red[w * 64 + lane];
#pragma unroll
      for (int j = 0; j < 4; ++j) store(4 * (lane >> 4) + j, blk * 16 + (lane & 15), t[j]);
    }
    __syncthreads();
  }
}

constexpr int LDS_BYTES = 147456;
__global__ void __launch_bounds__(512, 2) hybrid_fwd(Params p) {
  extern __shared__ __attribute__((aligned(16))) unsigned char lds[];
  cg::grid_group grid = cg::this_grid();
  const int G = gridDim.x;
  const int wave_s = __builtin_amdgcn_readfirstlane((int)__builtin_amdgcn_workitem_id_x() >> 6);
  LAS unsigned char* ldsl = (LAS unsigned char*)lds;
  unsigned char* ws = p.ws;
  bf16_t* HY = (bf16_t*)(ws + WS_HY); bf16_t* P = (bf16_t*)(ws + WS_P);
  float* xmeta = (float*)(ws + WS_XMETA);

#ifndef PH_MASK
#define PH_MASK 0xFFFF
#endif
  if (TIDX < 2) ((LAS unsigned*)(ldsl + LDS_BYTES - 64))[TIDX] = 0u;
  __syncthreads();
  if (PH_MASK & 1) phase_prologue(p, ldsl, wave_s);
  grid.sync();
  const XcdBarrier bar = xcd_barrier_post((unsigned*)(ws + WS_BAR), (volatile LAS unsigned*)(ldsl + LDS_BYTES - 64), wave_s);
#define GSYNC() xcd_barrier(bar, wave_s)
#pragma unroll 1
  for (int layer = 0; layer < DEPTH; ++layer) {
    const float lambda_init = (layer == 0) ? 0.2f : (0.8f - 0.6f * 0.7408182206817179f);
    const float* res_meta = (layer == 0) ? p.meta : xmeta; const float* res_body = (layer == 0) ? p.x : p.out;
    if (PH_MASK & 2) phase_rmsnorm(res_meta, res_body, p.norm_w + layer * DM, HY, wave_s);
    GSYNC();
    if (PH_MASK & 4) { pg8::Gemm g{HY, (const bf16_t*)(ws + WS_WIN) + (size_t)layer * INP * DM, MP, INP, DM, DM}; pg8::StaticOrder S; S.init(MP, INP, G, (int)blockIdx.x);
      pg8::EpiBf16 E{P, INP};
      pg8::gemm_phase<pg8::EpiBf16, pg8::StaticOrder, true, true>(ldsl, g, S, E, wave_s); }
    GSYNC();
    if (PH_MASK & 8) phase_post1(p, layer, wave_s);
    GSYNC();
    if (PH_MASK & 16) { pg8::Gemm g{P + C_CQ, (const bf16_t*)(ws + WS_WUQ) + (size_t)layer * 768 * 384, MP, 768, 384, INP}; pg8::StaticOrder S; S.init(MP, 768, G, (int)blockIdx.x);
      pg8::EpiBf16 E{(bf16_t*)(ws + WS_QC), 768};
      pg8::gemm_phase<pg8::EpiBf16, pg8::StaticOrder, true, true>(ldsl, g, S, E, wave_s); }
    if (PH_MASK & 16) { pg8::Gemm g{P + C_CKV, (const bf16_t*)(ws + WS_WUKV) + (size_t)layer * 1024 * 256, SEQ, 1024, 256, INP}; pg8::StaticOrder S; S.init(SEQ, 1024, G, (int)((blockIdx.x + 195) % G));
      pg8::EpiBf16 E{(bf16_t*)(ws + WS_KVC), 1024};
      pg8::gemm_phase<pg8::EpiBf16, pg8::StaticOrder, true, true>(ldsl, g, S, E, wave_s);
      bf16_t* kvc = (bf16_t*)(ws + WS_KVC);
      small_gemm16(P + (size_t)SEQ * INP + C_CKV, INP, g.Bt, 1024, 256, [=](int r, int c, float v) { kvc[(size_t)(SEQ + r) * 1024 + c] = (bf16_t)f2bf(v); }, ldsl, wave_s); }
    if (PH_MASK & 16) { pg8::Gemm g{(const bf16_t*)(ws + WS_POOL), (const bf16_t*)(ws + WS_WD) + (size_t)layer * 512 * 512, MP, 512, 512, 512}; pg8::StaticOrder S; S.init(MP, 512, G, (int)((blockIdx.x + 199) % G));
      pg8::EpiBf16 E{P + C_DU, INP};
      pg8::gemm_phase<pg8::EpiBf16, pg8::StaticOrder, true, true>(ldsl, g, S, E, wave_s); }
    GSYNC();
    if (PH_MASK & 32) phase_post2(p, layer, wave_s);
    GSYNC();
    if (PH_MASK & 64) phase_attn(p, layer, (char*)lds, layer, wave_s);
#ifdef PROBE_DUP_ATT
    GSYNC(); if (layer == 0) phase_attn(p, layer, (char*)lds, 4, wave_s);
#endif
    GSYNC();
    if (PH_MASK & 128) phase_post3(p, layer, lambda_init, wave_s);
    GSYNC();
    if (PH_MASK & 256) { pg8::Gemm g{HY, (const bf16_t*)(ws + WS_WOUT) + (size_t)layer * DM * DM, SEQ, DM, DM, DM}; pg8::StaticOrder S; S.init(SEQ, DM, G, (int)blockIdx.x);
      pg8::EpiRes E{res_meta, res_body, (layer == 0) ? xmeta : nullptr, p.out, DM, NMETA, LROWS};
      pg8::gemm_phase<pg8::EpiRes, pg8::StaticOrder, true, true>(ldsl, g, S, E, wave_s);
      { const float* rb = res_body; float* ob = p.out;
        small_gemm16(HY + (size_t)SEQ * DM, DM, g.Bt, DM, DM, [=](int r, int c, float v) { const size_t i = (size_t)(SEQ - NMETA + r) * DM + c; ob[i] = rb[i] + v; }, ldsl, wave_s); } }
    if (layer + 1 < DEPTH) GSYNC();
  }
}

extern "C" void kernel_launch(void* const* d_in, const int* in_sizes, int n_in, void* d_out, int out_size, void* d_ws, size_t ws_size, hipStream_t stream) {
  static int grid = 0;
  if (grid == 0) {
    if (n_in != 19 || in_sizes[0] != SEQ * DM || out_size != SEQ * DM || ws_size < WS_END) {
      fprintf(stderr, "kernel_launch: unexpected shapes: n_in %d in0 %d out %d ws %zu (need %zu)\n", n_in, n_in > 0 ? in_sizes[0] : -1, out_size, ws_size, (size_t)WS_END); grid = -1; return; }
    int dev = 0, cus = 0, per_cu = 0;
    hipGetDevice(&dev); hipDeviceGetAttribute(&cus, hipDeviceAttributeMultiprocessorCount, dev);
    if (hipFuncSetAttribute((const void*)hybrid_fwd, hipFuncAttributeMaxDynamicSharedMemorySize, LDS_BYTES) != hipSuccess) { fprintf(stderr, "kernel_launch: hipFuncSetAttribute failed\n"); grid = -1; return; }
    if (hipOccupancyMaxActiveBlocksPerMultiprocessor(&per_cu, (const void*)hybrid_fwd, 512, LDS_BYTES) != hipSuccess || per_cu < 1) { fprintf(stderr, "kernel_launch: occupancy query says %d\n", per_cu); per_cu = 1; }
    (void)hipGetLastError();
    grid = cus * 1;
  }
  if (grid < 0) return;
  Params p{};
  const float** fp = (const float**)&p;
  for (int i = 0; i < 19; ++i) fp[i] = (const float*)d_in[i];
  p.out = (float*)d_out; p.ws = (unsigned char*)d_ws;
  for (int j = 0; j < 8; ++j) p.inv_a[j] = (float)pow(500000.0, -(double)(2 * j) / 16.0);
  for (int j = 0; j < 32; ++j) { p.inv_b[j] = (float)pow(10000.0, -(double)(2 * j) / 64.0); p.inv_c[j] = (float)pow(500000.0, -(double)(2 * j) / 64.0); }
  void* args[] = {&p};
  hipError_t e = hipLaunchCooperativeKernel((const void*)hybrid_fwd, dim3(grid), dim3(512), args, LDS_BYTES, stream);
  if (e != hipSuccess) fprintf(stderr, "kernel_launch: cooperative launch failed: %s (grid %d)\n", hipGetErrorString(e), grid);
}
```
